# Optimizing an MI355X kernel written in HIP

```python
import jax, jax.numpy as jnp
from jax import lax
import numpy as np


D_MODEL = 2048
BATCH = 4
SEQ = 2048
DEPTH = 2

N_META = 16
CONV_WIDTH = D_MODEL
CONV_TAPS = 3
ATTN_HEADS = 32
ATTN_KV_HEADS = 8
ATTN_HEAD_DIM = D_MODEL // ATTN_HEADS
ATTN_GROUP = ATTN_HEADS // ATTN_KV_HEADS
WINDOW = 128
ATTN_BLOCK = 128
ROPE_THETA = 500000.0
ROPE_DIM = ATTN_HEAD_DIM // 4
MLSTM_HEADS = 8
MLSTM_V_DIM = D_MODEL // MLSTM_HEADS
MLSTM_QK_DIM = MLSTM_V_DIM // 2
MLSTM_CHUNK = 128
MLP_HIDDEN = 4 * D_MODEL
N_BRANCHES = 3
NORM_EPS = 1e-6
NEG_INF = -1e30
IN_SPLIT_SIZES = (CONV_WIDTH, CONV_WIDTH, CONV_WIDTH,
                  ATTN_HEADS * ATTN_HEAD_DIM, ATTN_KV_HEADS * ATTN_HEAD_DIM, ATTN_KV_HEADS * ATTN_HEAD_DIM,
                  MLSTM_HEADS * MLSTM_QK_DIM, MLSTM_HEADS * MLSTM_QK_DIM,
                  MLSTM_HEADS * MLSTM_V_DIM, MLSTM_HEADS * MLSTM_V_DIM,
                  MLSTM_HEADS, MLSTM_HEADS, MLSTM_HEADS, MLSTM_HEADS,
                  N_BRANCHES * D_MODEL)
IN_COLS = sum(IN_SPLIT_SIZES)

kernel_name = 'hybrid_gated_conv_swa_mlstm_encoder'


def rms_norm(x, g):
    xf = x.astype(jnp.float32)
    y = xf * lax.rsqrt(jnp.mean(xf * xf, axis=-1, keepdims=True) + NORM_EPS)
    return (y * g.astype(jnp.float32)).astype(x.dtype)


def rope_tables(length):
    pos = jnp.arange(length, dtype=jnp.float32)
    inv_freq = ROPE_THETA ** (-jnp.arange(0, ROPE_DIM, 2, dtype=jnp.float32) / ROPE_DIM)
    ang = pos[:, None] * inv_freq[None, :]
    return jnp.cos(ang), jnp.sin(ang)


def apply_partial_rope(x, cos, sin):
    half = ROPE_DIM // 2
    xr = x[..., :ROPE_DIM].astype(jnp.float32)
    x1, x2 = xr[..., :half], xr[..., half:]
    c = cos[None, :, None, :]
    s = sin[None, :, None, :]
    rot = jnp.concatenate([x1 * c - x2 * s, x2 * c + x1 * s], axis=-1).astype(x.dtype)
    return jnp.concatenate([rot, x[..., ROPE_DIM:]], axis=-1)


def short_conv(xc, bg, cg, w, b):
    u = cg * xc
    up = jnp.pad(u, ((0, 0), (1, 1), (0, 0)))
    y = up[:, :-2] * w[0] + up[:, 1:-1] * w[1] + up[:, 2:] * w[2] + b
    return bg * y


def sink_softmax(scores, visible, sink):
    scores = jnp.where(visible, scores, NEG_INF)
    mx = jnp.maximum(jnp.max(scores, axis=-1, keepdims=True), sink)
    p = jnp.exp(scores - mx)
    return p / (jnp.sum(p, axis=-1, keepdims=True) + jnp.exp(sink - mx))


def window_attention(q, k, v, sink):
    bsz, length = q.shape[0], q.shape[1]
    s_len = length - N_META
    nb = s_len // ATTN_BLOCK
    hd = ATTN_HEAD_DIM
    kvh = ATTN_KV_HEADS
    scale = hd ** -0.5
    q = q.reshape(bsz, length, kvh, ATTN_GROUP, hd)
    qm, qr = q[:, :N_META], q[:, N_META:]
    km, kr = k[:, :N_META], k[:, N_META:]
    vm, vr = v[:, :N_META], v[:, N_META:]
    sink_b = sink.astype(jnp.float32).reshape(kvh, ATTN_GROUP)

    def band(a):
        a = a.reshape(bsz, nb, ATTN_BLOCK, kvh, hd)
        a = jnp.pad(a, ((0, 0), (1, 1), (0, 0), (0, 0), (0, 0)))
        return jnp.concatenate([a[:, :-2], a[:, 1:-1], a[:, 2:]], axis=2)

    def with_meta(a_meta, a_band):
        a_meta = jnp.broadcast_to(a_meta[:, None], (bsz, nb, N_META, kvh, hd))
        return jnp.concatenate([a_meta, a_band], axis=2)

    kw = with_meta(km, band(kr))
    vw = with_meta(vm, band(vr))
    blk = jnp.arange(nb)
    qi = blk[:, None] * ATTN_BLOCK + jnp.arange(ATTN_BLOCK)[None, :]
    ki = (blk[:, None] - 1) * ATTN_BLOCK + jnp.arange(3 * ATTN_BLOCK)[None, :]
    vis = ((ki[:, None, :] >= 0) & (ki[:, None, :] < s_len)
           & (jnp.abs(qi[:, :, None] - ki[:, None, :]) <= WINDOW))
    vis = jnp.concatenate([jnp.ones((nb, ATTN_BLOCK, N_META), dtype=bool), vis], axis=-1)
    qb = qr.reshape(bsz, nb, ATTN_BLOCK, kvh, ATTN_GROUP, hd)
    sc = jnp.einsum('bnqkgd,bnskd->bnkgqs', qb, kw, preferred_element_type=jnp.float32) * scale
    pr = sink_softmax(sc, vis[None, :, None, None], sink_b[None, None, :, :, None, None])
    out_r = jnp.einsum('bnkgqs,bnskd->bnqkgd', pr.astype(v.dtype), vw)
    out_r = out_r.reshape(bsz, s_len, ATTN_HEADS, hd)

    km2 = jnp.concatenate([km, kr[:, :ATTN_BLOCK]], axis=1)
    vm2 = jnp.concatenate([vm, vr[:, :ATTN_BLOCK]], axis=1)
    mpos = jnp.arange(N_META)
    tpos = jnp.arange(ATTN_BLOCK)
    vis_m = jnp.concatenate([jnp.ones((N_META, N_META), dtype=bool),
                             (N_META + tpos[None, :] - mpos[:, None]) <= WINDOW], axis=-1)
    sc_m = jnp.einsum('bqkgd,bskd->bkgqs', qm, km2, preferred_element_type=jnp.float32) * scale
    pr_m = sink_softmax(sc_m, vis_m[None, None, None], sink_b[None, :, :, None, None])
    out_m = jnp.einsum('bkgqs,bskd->bqkgd', pr_m.astype(v.dtype), vm2)
    out_m = out_m.reshape(bsz, N_META, ATTN_HEADS, hd)
    return jnp.concatenate([out_m, out_r], axis=1)


def mlstm_chunkwise(q, k, v, log_i, log_f):
    bsz, t_len, nh, dqk = q.shape
    dv = v.shape[-1]
    nc = t_len // MLSTM_CHUNK

    def to_chunks(a):
        a = a.reshape((bsz, nc, MLSTM_CHUNK) + a.shape[2:])
        return jnp.moveaxis(a, 1, 0)

    xs = tuple(to_chunks(a) for a in (q, k, v, log_i, log_f))
    lower = jnp.tril(jnp.ones((MLSTM_CHUNK, MLSTM_CHUNK), dtype=bool))

    def step(carry, inp):
        c_mat, n_vec, m_st = carry
        qc, kc, vc, li, lf = inp
        bcum = jnp.cumsum(lf, axis=1)
        dmat = bcum[:, :, None, :] - bcum[:, None, :, :] + li[:, None, :, :]
        dmat = jnp.where(lower[None, :, :, None], dmat, NEG_INF)
        inter = bcum + m_st[:, None, :]
        m_t = jnp.maximum(inter, jnp.max(dmat, axis=2))
        wts = jnp.exp(dmat - m_t[:, :, None, :])
        sc = jnp.einsum('bthd,bshd->btsh', qc, kc) * wts
        a = jnp.exp(inter - m_t)
        num = (jnp.einsum('btsh,bshe->bthe', sc, vc)
               + a[..., None] * jnp.einsum('bthd,bhde->bthe', qc, c_mat))
        den = jnp.sum(sc, axis=2) + a * jnp.einsum('bthd,bhd->bth', qc, n_vec)
        den = jnp.maximum(jnp.abs(den), jnp.exp(-m_t))
        h = num / den[..., None]
        total = bcum[:, -1]
        g = total[:, None, :] - bcum + li
        m_new = jnp.maximum(total + m_st, jnp.max(g, axis=1))
        decay = jnp.exp(total + m_st - m_new)
        wg = jnp.exp(g - m_new[:, None, :])
        c_mat = decay[..., None, None] * c_mat + jnp.einsum('bsh,bshd,bshe->bhde', wg, kc, vc)
        n_vec = decay[..., None] * n_vec + jnp.einsum('bsh,bshd->bhd', wg, kc)
        return (c_mat, n_vec, m_new), h

    init = (jnp.zeros((bsz, nh, dqk, dv), jnp.float32),
            jnp.zeros((bsz, nh, dqk), jnp.float32),
            jnp.zeros((bsz, nh), jnp.float32))
    _, hs = lax.scan(step, init, xs)
    return jnp.moveaxis(hs, 0, 1).reshape(bsz, t_len, nh, dv)


def pad_time(a, n, front, value=0.0):
    cfg = [(0, 0)] * a.ndim
    cfg[1] = (n, 0) if front else (0, n)
    return jnp.pad(a, cfg, constant_values=value)


def mlstm_direction(q, k, v, log_i, log_f, reverse):
    pad = MLSTM_CHUNK - N_META
    length = q.shape[1]
    if reverse:
        q, k, v, log_i, log_f = [jnp.flip(a, axis=1) for a in (q, k, v, log_i, log_f)]
    front = not reverse
    h = mlstm_chunkwise(pad_time(q, pad, front), pad_time(k, pad, front), pad_time(v, pad, front),
                        pad_time(log_i, pad, front, NEG_INF), pad_time(log_f, pad, front))
    h = h[:, pad:] if front else h[:, :length]
    return jnp.flip(h, axis=1) if reverse else h


def mlstm_branch(q, k, v, o_pre, i_fw, f_fw, i_bw, f_bw, b_i, b_f, head_gain):
    bsz, length = q.shape[0], q.shape[1]
    f32 = jnp.float32
    qh = q.astype(f32).reshape(bsz, length, MLSTM_HEADS, MLSTM_QK_DIM)
    kh = k.astype(f32).reshape(bsz, length, MLSTM_HEADS, MLSTM_QK_DIM) * (MLSTM_QK_DIM ** -0.5)
    vh = v.astype(f32).reshape(bsz, length, MLSTM_HEADS, MLSTM_V_DIM)
    b_i = b_i.astype(f32)
    b_f = b_f.astype(f32)
    h_fw = mlstm_direction(qh, kh, vh, i_fw.astype(f32) + b_i[0],
                           jax.nn.log_sigmoid(f_fw.astype(f32) + b_f[0]), False)
    h_bw = mlstm_direction(qh, kh, vh, i_bw.astype(f32) + b_i[1],
                           jax.nn.log_sigmoid(f_bw.astype(f32) + b_f[1]), True)
    h = h_fw + h_bw
    h = h * lax.rsqrt(jnp.mean(h * h, axis=-1, keepdims=True) + NORM_EPS)
    h = h * head_gain.astype(f32).reshape(MLSTM_HEADS, MLSTM_V_DIM)
    h = h.reshape(bsz, length, MLSTM_HEADS * MLSTM_V_DIM) * jax.nn.sigmoid(o_pre.astype(f32))
    return h.astype(q.dtype)


def setup_inputs(seed: int = 0) -> dict:
    key = jax.random.key(seed)
    ks = jax.random.split(key, 20)
    nrm = jax.random.normal
    f32 = jnp.float32
    return {
        'x': nrm(ks[0], (BATCH, SEQ, D_MODEL), f32),
        'meta_tokens': nrm(ks[1], (N_META, D_MODEL), f32),
        'w_in': nrm(ks[2], (DEPTH, D_MODEL, IN_COLS), f32) * D_MODEL ** -0.5,
        'b_gate': nrm(ks[3], (DEPTH, N_BRANCHES * D_MODEL), f32) * 0.1,
        'conv_w': nrm(ks[4], (DEPTH, CONV_TAPS, CONV_WIDTH), f32) * 0.5,
        'conv_b': nrm(ks[5], (DEPTH, CONV_WIDTH), f32) * 0.01,
        'attn_sink': nrm(ks[6], (DEPTH, ATTN_HEADS), f32) * 0.5,
        'mlstm_b_i': nrm(ks[7], (DEPTH, 2, MLSTM_HEADS), f32) * 0.1,
        'mlstm_b_f': 3.0 + nrm(ks[8], (DEPTH, 2, MLSTM_HEADS), f32) * 0.5,
        'mlstm_head_gain': 1.0 + nrm(ks[9], (DEPTH, MLSTM_HEADS * MLSTM_V_DIM), f32) * 0.02,
        'w_conv_proj': nrm(ks[10], (DEPTH, CONV_WIDTH, D_MODEL), f32) * CONV_WIDTH ** -0.5,
        'w_attn_proj': nrm(ks[11], (DEPTH, ATTN_HEADS * ATTN_HEAD_DIM, D_MODEL), f32) * (ATTN_HEADS * ATTN_HEAD_DIM) ** -0.5,
        'w_mlstm_proj': nrm(ks[12], (DEPTH, MLSTM_HEADS * MLSTM_V_DIM, D_MODEL), f32) * (MLSTM_HEADS * MLSTM_V_DIM) ** -0.5,
        'w_out': nrm(ks[13], (DEPTH, D_MODEL, D_MODEL), f32) * D_MODEL ** -0.5,
        'norm_mix': 1.0 + nrm(ks[14], (DEPTH, D_MODEL), f32) * 0.02,
        'norm_mlp': 1.0 + nrm(ks[15], (DEPTH, D_MODEL), f32) * 0.02,
        'mlp_w1': nrm(ks[16], (DEPTH, D_MODEL, MLP_HIDDEN), f32) * D_MODEL ** -0.5,
        'mlp_w2': nrm(ks[17], (DEPTH, MLP_HIDDEN, D_MODEL), f32) * MLP_HIDDEN ** -0.5,
        'final_norm': 1.0 + nrm(ks[18], (D_MODEL,), f32) * 0.02,
    }


def reference(x, meta_tokens, w_in, b_gate, conv_w, conv_b, attn_sink, mlstm_b_i, mlstm_b_f,
              mlstm_head_gain, w_conv_proj, w_attn_proj, w_mlstm_proj, w_out, norm_mix, norm_mlp,
              mlp_w1, mlp_w2, final_norm):
    bsz = x.shape[0]
    meta = jnp.broadcast_to(meta_tokens[None].astype(x.dtype), (bsz, N_META, D_MODEL))
    h = jnp.concatenate([meta, x], axis=1)
    length = h.shape[1]
    cos, sin = rope_tables(length)
    split_at = np.cumsum(IN_SPLIT_SIZES)[:-1].tolist()
    for layer in range(DEPTH):
        xn = rms_norm(h, norm_mix[layer])
        w_parts = jnp.split(w_in[layer], split_at, axis=1)
        (c_x, c_b, c_c, a_q, a_k, a_v, m_q, m_k, m_v, m_o,
         m_if, m_ff, m_ib, m_fb, g_pre) = [xn @ w for w in w_parts]
        y_conv = short_conv(c_x, c_b, c_c, conv_w[layer], conv_b[layer])
        q = apply_partial_rope(a_q.reshape(bsz, length, ATTN_HEADS, ATTN_HEAD_DIM), cos, sin)
        k = apply_partial_rope(a_k.reshape(bsz, length, ATTN_KV_HEADS, ATTN_HEAD_DIM), cos, sin)
        v = a_v.reshape(bsz, length, ATTN_KV_HEADS, ATTN_HEAD_DIM)
        y_attn = window_attention(q, k, v, attn_sink[layer]).reshape(bsz, length, ATTN_HEADS * ATTN_HEAD_DIM)
        y_mlstm = mlstm_branch(m_q, m_k, m_v, m_o, m_if, m_ff, m_ib, m_fb,
                               mlstm_b_i[layer], mlstm_b_f[layer], mlstm_head_gain[layer])
        gates = jax.nn.sigmoid((g_pre + b_gate[layer]).astype(jnp.float32)).astype(x.dtype)
        gates = gates.reshape(bsz, length, N_BRANCHES, D_MODEL)
        merged = (gates[:, :, 0] * (y_conv @ w_conv_proj[layer])
                  + gates[:, :, 1] * (y_attn @ w_attn_proj[layer])
                  + gates[:, :, 2] * (y_mlstm @ w_mlstm_proj[layer]))
        h = h + merged @ w_out[layer]
        xn = rms_norm(h, norm_mlp[layer])
        h = h + jnp.square(jax.nn.relu(xn @ mlp_w1[layer])) @ mlp_w2[layer]
    return rms_norm(h, final_norm)[:, N_META:]
```

```cpp
#include <hip/hip_runtime.h>
#include <hip/hip_cooperative_groups.h>
#include <cstdio>
namespace cg = cooperative_groups;

#define LAS __attribute__((address_space(3)))
#define DI __device__ __forceinline__
typedef unsigned short bf16_t;
typedef short bf16x8 __attribute__((ext_vector_type(8)));
typedef float f32x4 __attribute__((ext_vector_type(4)));
typedef float f32x2 __attribute__((ext_vector_type(2)));
typedef unsigned u32x4 __attribute__((ext_vector_type(4)));
typedef unsigned u32x2 __attribute__((ext_vector_type(2)));
typedef __bf16 bf16x2_t __attribute__((ext_vector_type(2)));
#define MFMA16(a, b, c) __builtin_amdgcn_mfma_f32_16x16x32_bf16((a), (b), (c), 0, 0, 0)

constexpr int DM = 2048, TOK = 8256, TP = 8448, META0 = 8192;
constexpr int INC = 21536, NIN = 21760, PC = 15360, GC = 6144, HID = 8192;
constexpr int oCX = 0, oCB = 2048, oCC = 4096, oAQ = 6144, oAK = 8192, oAV = 8704, oMQ = 9216, oMK = 10240, oMV = 11264, oMO = 13312;
constexpr int LDS_BYTES = 144 * 1024;
constexpr int TILES_PER_LAYER = 5792;

struct Params {
    const float *x, *meta, *w_in, *b_gate, *conv_w, *conv_b, *sink, *mbi, *mbf, *gain, *w_cp, *w_ap, *w_mp, *w_out, *nmix, *nmlp, *w1, *w2, *fnorm;
    float* out;
    bf16_t *Wt_in, *Wt_c, *Wt_a, *Wt_m, *Wt_o, *Wt1, *Wt2;
    float* h; bf16_t* xn; bf16_t* P; bf16_t* G; float* gt; bf16_t *yc, *ya, *ym; float* hm; bf16_t* mg; float* ropec; float* ropes; unsigned* bar;
};

DI unsigned pack2(float lo, float hi) { f32x2 v = {lo, hi}; bf16x2_t b = __builtin_convertvector(v, bf16x2_t); return __builtin_bit_cast(unsigned, b); }
DI bf16_t f2bf(float f) { return (bf16_t)(pack2(f, 0.f) & 0xffffu); }
DI float bf_lo(unsigned u) { return __uint_as_float(u << 16); }
DI float bf_hi(unsigned u) { return __uint_as_float(u & 0xffff0000u); }
DI float bf2f(short s) { return __uint_as_float(((unsigned)(unsigned short)s) << 16); }
DI float wave_sum(float v) {
#pragma unroll
    for (int o = 32; o; o >>= 1) v += __shfl_xor(v, o);
    return v;
}
DI int tid_() { int t = threadIdx.x; asm volatile("" : "+v"(t)); return t; }
DI float sigmoidf_(float x) { return __builtin_amdgcn_rcpf(1.f + __expf(-x)); }


#define XB_TMO      128
#define XB_XCNT(j)  (256  + 64 * (j))
#define XB_XSUB(j)  (1280 + 64 * (j))
#define XB_XGEN(j)  (2304 + 64 * (j))
#define XB_TOP      3328
#define XB_TOPGEN   3392
#define XCD_BAR_WORDS 3456
#define XB_SPIN_CAP (1u << 18)
DI unsigned xb_ld(unsigned* p)              { return __hip_atomic_load(p, __ATOMIC_RELAXED, __HIP_MEMORY_SCOPE_AGENT); }
DI unsigned xb_add(unsigned* p, unsigned v) { return __hip_atomic_fetch_add(p, v, __ATOMIC_RELAXED, __HIP_MEMORY_SCOPE_AGENT); }
DI unsigned xb_xcc_id() { return (unsigned)__builtin_amdgcn_s_getreg((3 << 11) | 20) & 0xFu; }
#define XB_SPIN(cond, bar) do { unsigned _sp = 0; while (cond) { __builtin_amdgcn_s_sleep(1); \
    if ((++_sp & 255u) == 0u) { if (xb_ld(&(bar)[XB_TMO])) break; if (_sp > XB_SPIN_CAP) { atomicAdd(&(bar)[XB_TMO], 1u); break; } } } } while (0)
struct XcdBarrier { unsigned* bar; unsigned x; volatile LAS unsigned* st; };
DI XcdBarrier xcd_barrier_post(unsigned* bar, volatile LAS unsigned* st) {
    XcdBarrier b; b.bar = bar; b.x = xb_xcc_id(); b.st = st;
    if (threadIdx.x == 0) (void)xb_add(&bar[XB_XCNT(b.x)], 1u);
    return b;
}
DI void xcd_barrier_complete(unsigned* bar, unsigned x, unsigned& nloc, unsigned& nx) {
    const unsigned G = gridDim.x * gridDim.y * gridDim.z;
    unsigned sum, cnt, mine, sp = 0u;
    for (;;) {
        sum = 0u; cnt = 0u; mine = 0u;
#pragma unroll
        for (unsigned j = 0; j < 16; ++j) { const unsigned c = xb_ld(&bar[XB_XCNT(j)]); sum += c; cnt += (c > 0u) ? 1u : 0u; mine = (j == x) ? c : mine; }
        if (sum == G) break;
        __builtin_amdgcn_s_sleep(1);
        if ((++sp & 255u) == 0u) { if (xb_ld(&bar[XB_TMO])) break; if (sp > XB_SPIN_CAP) { atomicAdd(&bar[XB_TMO], 1u); break; } }
    }
    nloc = mine > 0u ? mine : 1u; nx = cnt > 0u ? cnt : 1u;
}
DI void xcd_barrier(const XcdBarrier& b) {
    asm volatile("s_waitcnt vmcnt(0)" ::: "memory");
    __syncthreads();
    if (threadIdx.x == 0) {
        unsigned* bar = b.bar;
        __builtin_amdgcn_s_waitcnt(0);
        unsigned nloc = b.st[0], nx = b.st[1];
        if (nloc == 0u) { xcd_barrier_complete(bar, b.x, nloc, nx); b.st[0] = nloc; b.st[1] = nx; }
        const unsigned old = xb_add(&bar[XB_XSUB(b.x)], 1u);
        const unsigned gen = old / nloc;
        if (old + 1u == (gen + 1u) * nloc) {
            __builtin_amdgcn_fence(__ATOMIC_RELEASE, "agent");
            asm volatile("s_waitcnt vmcnt(0)" ::: "memory");
            const unsigned og = xb_add(&bar[XB_TOP], 1u);
            const unsigned tg = og / nx;
            if (og + 1u == (tg + 1u) * nx) xb_add(&bar[XB_TOPGEN], 1u);
            else XB_SPIN(xb_ld(&bar[XB_TOPGEN]) == tg, bar);
            __builtin_amdgcn_fence(__ATOMIC_ACQUIRE, "agent");
            xb_add(&bar[XB_XGEN(b.x)], 1u);
            asm volatile("s_waitcnt vmcnt(0)" ::: "memory");
        } else {
            XB_SPIN(xb_ld(&bar[XB_XGEN(b.x)]) == gen, bar);
            __builtin_amdgcn_fence(__ATOMIC_ACQUIRE, "agent");
            asm volatile("s_waitcnt vmcnt(0)" ::: "memory");
        }
    }
    __syncthreads();
}

namespace pg8 {
constexpr int BM = 256, BK = 64, HALF = 128, HTB = HALF * BK * 2, STAGE_BYTES = 8 * HTB, NXCD = 8, WGM = 8;
DI int lds_byte(int r, int c) { const int st = (r >> 4) * 2 + (c >> 5), rr = r & 15, cc = c & 31, ob = rr * 64 + cc * 2; return st * 1024 + (ob ^ (((ob >> 9) & 1) << 5)); }
DI void stage_rc(int b, int& R, int& C) { const int st = b / 1024, sb = b % 1024, swz = sb ^ (((sb >> 9) & 1) << 5); R = (st >> 1) * 16 + swz / 64; C = (st & 1) * 32 + (swz % 64) / 2; }
DI int perm32(int rho) { const int n = rho >> 4, i = rho & 15; return 8 * (i >> 2) + 4 * n + (i & 3); }
struct Unit { int pm, pn, z; };

struct Sched {
    int nM, nN, nwg, G, c, nz;
    const char *A0, *B0;
    size_t tstep, zA, zB;
    DI void init(int M, int N, int K, int G_, int c_, int nz_) { nM = M / BM; nN = N / BM; nwg = nM * nN; G = G_; c = c_; nz = nz_; tstep = (size_t)BM * K * 2; zA = zB = 0; }
    DI bool next(int i, Unit& u) const {
        const int z = i % nz, ii = i / nz;
        const long L = (long)ii * G + c; if (L >= nwg) return false;
        int wgid = (int)L; { const int q = nwg / NXCD, r = nwg % NXCD, xcd = wgid % NXCD, off = wgid / NXCD; wgid = (xcd < r ? xcd * (q + 1) : r * (q + 1) + (xcd - r) * q) + off; }
        const int nig = WGM * nN, gid = wgid / nig, fm = gid * WGM, gsz = (nM - fm) < WGM ? (nM - fm) : WGM;
        u.pm = fm + ((wgid % nig) % gsz); u.pn = (wgid % nig) / gsz; u.z = z; return true;
    }
    DI const char* aBase(const Unit& u) const { return A0 + (size_t)u.z * zA + (size_t)u.pm * tstep; }
    DI const char* bBase(const Unit& u) const { return B0 + (size_t)u.z * zB + (size_t)u.pn * tstep; }
};

template <class Epi>
DI void gemm_phase(LAS unsigned char* lds, const int K, const Sched& S, const Epi& E) {
    const int tid = tid_(), wid = __builtin_amdgcn_readfirstlane(tid >> 6), lane = tid & 63, wr = wid >> 2, wc = wid & 3, fr = lane & 15, fq = lane >> 4;
    const int nt = K / BK;
    unsigned voffA[2], voffB[2];
#pragma unroll
    for (int i = 0; i < 2; ++i) { int R, C; stage_rc(tid * 16 + i * 8192, R, C); const int Rb = Epi::PERM ? ((R & ~31) + perm32(R & 31)) : R;
        voffA[i] = (unsigned)(R * K + C) * 2u; voffB[i] = (unsigned)(Rb * K + C) * 2u; }
    const size_t kstep = (size_t)(BK * 2);
    const size_t hstep = (size_t)HALF * K * 2;
    const unsigned ldsw = (unsigned)wid * 1024u;
    const int aoff = lds_byte(wr * 64 + fr, fq * 8), boff = lds_byte(wc * 32 + fr, fq * 8);
#define PG8_SA(b, h) (((b) * 2 + (h)) * HTB)
#define PG8_SB(b, h) ((4 + (b) * 2 + (h)) * HTB)
#define PG8_STAGE(bufoff, gbase, voff) do { _Pragma("unroll") for (int _i = 0; _i < 2; ++_i) \
        __builtin_amdgcn_global_load_lds((const unsigned*)((const char*)(gbase) + (voff)[_i]), (LAS unsigned*)(lds + (bufoff) + ldsw + _i * 8192), 16, 0, 0); } while (0)
#define PG8_LDA(dst, b, h) do { _Pragma("unroll") for (int m = 0; m < 4; ++m) _Pragma("unroll") for (int k = 0; k < 2; ++k) dst[m][k] = *(const LAS bf16x8*)(lds + PG8_SA(b, h) + aoff + m * 2048 + k * 1024); } while (0)
#define PG8_LDB(dst, b, h) do { _Pragma("unroll") for (int n = 0; n < 2; ++n) _Pragma("unroll") for (int k = 0; k < 2; ++k) dst[n][k] = *(const LAS bf16x8*)(lds + PG8_SB(b, h) + boff + n * 2048 + k * 1024); } while (0)
#define PG8_MMA(ai, bj, At, Bt) do { __builtin_amdgcn_s_setprio(1); _Pragma("unroll") for (int m = 0; m < 4; ++m) _Pragma("unroll") for (int n = 0; n < 2; ++n) _Pragma("unroll") for (int k = 0; k < 2; ++k) \
        acc[ai][bj][m][n] = __builtin_amdgcn_mfma_f32_16x16x32_bf16(Bt[n][k], At[m][k], acc[ai][bj][m][n], 0, 0, 0); __builtin_amdgcn_s_setprio(0); } while (0)
#define PG8_WAIT_V(n) asm volatile("s_waitcnt vmcnt(" #n ")" ::: "memory")
#define PG8_WAIT_L(n) asm volatile("s_waitcnt lgkmcnt(" #n ")" ::: "memory")
#define PG8_BAR __builtin_amdgcn_s_barrier()
#define PG8_SCHED __builtin_amdgcn_sched_barrier(0)
    Unit cur, nxt; int ui = 0;
    if (!S.next(0, cur)) return;
    f32x4 acc[2][2][4][2];
#pragma unroll
    for (int a = 0; a < 2; ++a)
#pragma unroll
        for (int b = 0; b < 2; ++b)
#pragma unroll
            for (int m = 0; m < 4; ++m)
#pragma unroll
                for (int n = 0; n < 2; ++n) acc[a][b][m][n] = (f32x4){0.f, 0.f, 0.f, 0.f};
    bf16x8 At[4][2], B0[2][2], B1[2][2];
    const char* cA = S.aBase(cur); const char* cB = S.bBase(cur);
    PG8_STAGE(PG8_SB(0, 0), cB, voffB); PG8_STAGE(PG8_SA(0, 0), cA, voffA); PG8_STAGE(PG8_SB(0, 1), cB + hstep, voffB); PG8_STAGE(PG8_SA(0, 1), cA + hstep, voffA);
    if (wr == 1) PG8_BAR;
    PG8_WAIT_V(4); PG8_BAR;
    PG8_STAGE(PG8_SB(1, 0), cB + kstep, voffB); PG8_STAGE(PG8_SA(1, 0), cA + kstep, voffA); PG8_STAGE(PG8_SB(1, 1), cB + hstep + kstep, voffB);
    PG8_WAIT_V(6); PG8_BAR;
    for (;;) {
        const bool has_next = S.next(ui + 1, nxt);
        const char* nA = has_next ? S.aBase(nxt) : cA; const char* nB = has_next ? S.bBase(nxt) : cB;
        for (int t = 0; t < nt; t += 2) {
            const bool last = (t == nt - 2);
            const char* a1 = cA + (size_t)(t + 1) * kstep;
            const char* a2 = last ? nA : cA + (size_t)(t + 2) * kstep; const char* b2 = last ? nB : cB + (size_t)(t + 2) * kstep;
            const char* a3 = a2 + kstep; const char* b3 = b2 + kstep;
            PG8_LDB(B0, 0, 0); PG8_SCHED; PG8_LDA(At, 0, 0); PG8_STAGE(PG8_SA(1, 1), a1 + hstep, voffA);
            PG8_WAIT_L(8); PG8_BAR; PG8_WAIT_L(0); PG8_MMA(0, 0, At, B0); PG8_BAR; PG8_SCHED;
            PG8_LDB(B1, 0, 1); PG8_STAGE(PG8_SB(0, 0), b2, voffB);
            PG8_BAR; PG8_WAIT_L(0); PG8_MMA(0, 1, At, B1); PG8_BAR;
            PG8_LDA(At, 0, 1); PG8_STAGE(PG8_SA(0, 0), a2, voffA);
            PG8_BAR; PG8_WAIT_L(0); PG8_MMA(1, 0, At, B0); PG8_BAR; PG8_SCHED;
            PG8_STAGE(PG8_SB(0, 1), b2 + hstep, voffB);
            PG8_WAIT_V(6); PG8_BAR; PG8_MMA(1, 1, At, B1); PG8_BAR;
            PG8_LDB(B0, 1, 0); PG8_SCHED; PG8_LDA(At, 1, 0); PG8_STAGE(PG8_SA(0, 1), a2 + hstep, voffA);
            PG8_WAIT_L(8); PG8_BAR; PG8_WAIT_L(0); PG8_MMA(0, 0, At, B0); PG8_BAR; PG8_SCHED;
            PG8_LDB(B1, 1, 1); PG8_STAGE(PG8_SB(1, 0), b3, voffB);
            PG8_BAR; PG8_WAIT_L(0); PG8_MMA(0, 1, At, B1); PG8_BAR;
            PG8_LDA(At, 1, 1); PG8_STAGE(PG8_SA(1, 0), a3, voffA);
            PG8_BAR; PG8_WAIT_L(0); PG8_MMA(1, 0, At, B0); PG8_BAR; PG8_SCHED;
            PG8_STAGE(PG8_SB(1, 1), b3 + hstep, voffB);
            PG8_WAIT_V(6); PG8_BAR; PG8_MMA(1, 1, At, B1); PG8_BAR;
        }
        bool keep = false;
        if constexpr (Epi::CARRY) keep = E.carry(acc, cur, wr, wc, fr, fq); else E(acc, cur, wr, wc, fr, fq);
        if (!has_next) break;
        if (!keep) {
#pragma unroll
        for (int a = 0; a < 2; ++a)
#pragma unroll
            for (int b = 0; b < 2; ++b)
#pragma unroll
                for (int m = 0; m < 4; ++m)
#pragma unroll
                    for (int n = 0; n < 2; ++n) acc[a][b][m][n] = (f32x4){0.f, 0.f, 0.f, 0.f};
        }
        cur = nxt; cA = nA; cB = nB; ++ui;
    }
    PG8_WAIT_V(0);
    if (wr == 0) PG8_BAR;
    PG8_BAR;
#undef PG8_SA
#undef PG8_SB
#undef PG8_STAGE
#undef PG8_LDA
#undef PG8_LDB
#undef PG8_MMA
#undef PG8_WAIT_V
#undef PG8_WAIT_L
#undef PG8_BAR
#undef PG8_SCHED
}
}
using pg8::Unit;

struct EpiIn {
    static constexpr bool PERM = true, CARRY = false;
    bf16_t* P; bf16_t* G; float* gt; const float* bgate;
    DI void operator()(const f32x4 (&acc)[2][2][4][2], const Unit& u, int wr, int wc, int fr, int fq) const {
        asm volatile("" : "+v"(fr), "+v"(fq));
        const int row0 = u.pm * 256 + wr * 64 + fr;
        if (u.pn < 16) {
            const int col0 = oCX + u.pn * 128 + wc * 32 + 8 * fq;
#pragma unroll
            for (int ai = 0; ai < 2; ++ai)
#pragma unroll
                for (int m = 0; m < 4; ++m) { const f32x4 v0 = acc[ai][0][m][0] * acc[ai][1][m][0], v1 = acc[ai][0][m][1] * acc[ai][1][m][1];
                    u32x4 w; w.x = pack2(v0[0], v0[1]); w.y = pack2(v0[2], v0[3]); w.z = pack2(v1[0], v1[1]); w.w = pack2(v1[2], v1[3]);
                    *(u32x4*)(P + (size_t)(row0 + ai * 128 + m * 16) * PC + col0) = w; }
        } else if (u.pn < 60) {
            const int col0 = (u.pn < 24 ? (u.pn - 8) * 256 : u.pn * 256) + wc * 32 + 8 * fq;
#pragma unroll
            for (int ai = 0; ai < 2; ++ai)
#pragma unroll
                for (int m = 0; m < 4; ++m) { bf16_t* rowp = P + (size_t)(row0 + ai * 128 + m * 16) * PC + col0;
#pragma unroll
                    for (int bj = 0; bj < 2; ++bj) { const f32x4 v0 = acc[ai][bj][m][0], v1 = acc[ai][bj][m][1];
                        u32x4 w; w.x = pack2(v0[0], v0[1]); w.y = pack2(v0[2], v0[3]); w.z = pack2(v1[0], v1[1]); w.w = pack2(v1[2], v1[3]);
                        *(u32x4*)(rowp + bj * 128) = w; } }
        } else if (u.pn < 84) {
            const int col0 = (u.pn - 60) * 256 + wc * 32 + 8 * fq;
            f32x4 bv[2][2];
#pragma unroll
            for (int bj = 0; bj < 2; ++bj)
#pragma unroll
                for (int n = 0; n < 2; ++n) bv[bj][n] = *(const f32x4*)(bgate + col0 + bj * 128 + 4 * n);
#pragma unroll
            for (int ai = 0; ai < 2; ++ai)
#pragma unroll
                for (int m = 0; m < 4; ++m) { bf16_t* rowp = G + (size_t)(row0 + ai * 128 + m * 16) * GC + col0;
#pragma unroll
                    for (int bj = 0; bj < 2; ++bj) { const f32x4 v0 = acc[ai][bj][m][0] + bv[bj][0], v1 = acc[ai][bj][m][1] + bv[bj][1];
                        u32x4 w; w.x = pack2(sigmoidf_(v0[0]), sigmoidf_(v0[1])); w.y = pack2(sigmoidf_(v0[2]), sigmoidf_(v0[3]));
                        w.z = pack2(sigmoidf_(v1[0]), sigmoidf_(v1[1])); w.w = pack2(sigmoidf_(v1[2]), sigmoidf_(v1[3]));
                        *(u32x4*)(rowp + bj * 128) = w; } }
        } else {
            if (wc == 0) {
#pragma unroll
                for (int ai = 0; ai < 2; ++ai)
#pragma unroll
                    for (int m = 0; m < 4; ++m) { float* rowp = gt + (size_t)(row0 + ai * 128 + m * 16) * 32 + 8 * fq;
                        *(f32x4*)rowp = acc[ai][0][m][0]; *(f32x4*)(rowp + 4) = acc[ai][0][m][1]; }
            }
        }
    }
};
struct EpiBr {
    static constexpr bool PERM = false, CARRY = true;
    const bf16_t* G; bf16_t* mg;
    DI bool carry(f32x4 (&acc)[2][2][4][2], const Unit& u, int wr, int wc, int fr, int fq) const {
        asm volatile("" : "+v"(fr), "+v"(fq));
        const int row0 = u.pm * 256 + wr * 64 + fr, col0 = u.pn * 256 + wc * 32 + 4 * fq;
#pragma unroll
        for (int ai = 0; ai < 2; ++ai)
#pragma unroll
            for (int m = 0; m < 4; ++m) { const size_t row = (size_t)(row0 + ai * 128 + m * 16);
#pragma unroll
                for (int bj = 0; bj < 2; ++bj)
#pragma unroll
                    for (int n = 0; n < 2; ++n) { const int col = col0 + bj * 128 + n * 16;
                        const u32x2 g = *(const u32x2*)(G + row * GC + u.z * 2048 + col);
                        f32x4 f = {bf_lo(g.x), bf_hi(g.x), bf_lo(g.y), bf_hi(g.y)};
                        if (u.z < 2) { const u32x2 gn = *(const u32x2*)(G + row * GC + (u.z + 1) * 2048 + col);
                            f[0] *= __builtin_amdgcn_rcpf(fmaxf(bf_lo(gn.x), 1e-30f)); f[1] *= __builtin_amdgcn_rcpf(fmaxf(bf_hi(gn.x), 1e-30f));
                            f[2] *= __builtin_amdgcn_rcpf(fmaxf(bf_lo(gn.y), 1e-30f)); f[3] *= __builtin_amdgcn_rcpf(fmaxf(bf_hi(gn.y), 1e-30f));
                            acc[ai][bj][m][n] *= f; }
                        else { const f32x4 v = acc[ai][bj][m][n] * f; u32x2 w; w.x = pack2(v[0], v[1]); w.y = pack2(v[2], v[3]); *(u32x2*)(mg + row * 2048 + col) = w; } } }
        return u.z < 2;
    }
};
struct EpiRes {
    static constexpr bool PERM = false, CARRY = false;
    float* h;
    DI void operator()(const f32x4 (&acc)[2][2][4][2], const Unit& u, int wr, int wc, int fr, int fq) const {
        asm volatile("" : "+v"(fr), "+v"(fq));
        const int row0 = u.pm * 256 + wr * 64 + fr, col0 = u.pn * 256 + wc * 32 + 4 * fq;
#pragma unroll
        for (int ai = 0; ai < 2; ++ai)
#pragma unroll
            for (int m = 0; m < 4; ++m) { float* rowp = h + (size_t)(row0 + ai * 128 + m * 16) * 2048 + col0;
#pragma unroll
                for (int bj = 0; bj < 2; ++bj)
#pragma unroll
                    for (int n = 0; n < 2; ++n) { float* q = rowp + bj * 128 + n * 16; *(f32x4*)q = *(const f32x4*)q + acc[ai][bj][m][n]; } }
    }
};
struct EpiUp {
    static constexpr bool PERM = true, CARRY = false;
    bf16_t* act;
    DI void operator()(const f32x4 (&acc)[2][2][4][2], const Unit& u, int wr, int wc, int fr, int fq) const {
        asm volatile("" : "+v"(fr), "+v"(fq));
        const int row0 = u.pm * 256 + wr * 64 + fr, col0 = u.pn * 256 + wc * 32 + 8 * fq;
#pragma unroll
        for (int ai = 0; ai < 2; ++ai)
#pragma unroll
            for (int m = 0; m < 4; ++m) { bf16_t* rowp = act + (size_t)(row0 + ai * 128 + m * 16) * HID + col0;
#pragma unroll
                for (int bj = 0; bj < 2; ++bj) { f32x4 v0 = acc[ai][bj][m][0], v1 = acc[ai][bj][m][1];
#pragma unroll
                    for (int j = 0; j < 4; ++j) { const float a = fmaxf(v0[j], 0.f), b = fmaxf(v1[j], 0.f); v0[j] = a * a; v1[j] = b * b; }
                    u32x4 w; w.x = pack2(v0[0], v0[1]); w.y = pack2(v0[2], v0[3]); w.z = pack2(v1[0], v1[1]); w.w = pack2(v1[2], v1[3]);
                    *(u32x4*)(rowp + bj * 128) = w; } }
    }
};


struct ThinBr {
    const bf16_t* G; bf16_t* mg;
    DI void gate(int z, int m, int n, int cg, int fr, int fq, const f32x4& a, f32x4& t) const {
        const u32x2 g = *(const u32x2*)(G + (size_t)(META0 + m * 16 + fr) * GC + z * 2048 + cg * 64 + n * 16 + 4 * fq);
        t[0] += a[0] * bf_lo(g.x); t[1] += a[1] * bf_hi(g.x); t[2] += a[2] * bf_lo(g.y); t[3] += a[3] * bf_hi(g.y);
    }
    DI void store(int row, int col, const f32x4& v) const { u32x2 w; w.x = pack2(v[0], v[1]); w.y = pack2(v[2], v[3]); *(u32x2*)(mg + (size_t)(META0 + row) * 2048 + col) = w; }
};
struct ThinRes {
    float* h;
    DI void gate(int, int, int, int, int, int, const f32x4& a, f32x4& t) const { t += a; }
    DI void store(int row, int col, const f32x4& v) const { float* q = h + (size_t)(META0 + row) * 2048 + col;
#pragma unroll
        for (int j = 0; j < 4; ++j) (void)__hip_atomic_fetch_add(q + j, v[j], __ATOMIC_RELAXED, __HIP_MEMORY_SCOPE_AGENT); }
};
struct ThinUp {
    bf16_t* act;
    DI void gate(int, int, int, int, int, int, const f32x4& a, f32x4& t) const { t += a; }
    DI void store(int row, int col, const f32x4& v) const { const float a = fmaxf(v[0], 0.f), b = fmaxf(v[1], 0.f), c = fmaxf(v[2], 0.f), d = fmaxf(v[3], 0.f);
        u32x2 w; w.x = pack2(a * a, b * b); w.y = pack2(c * c, d * d); *(u32x2*)(act + (size_t)(META0 + row) * HID + col) = w; }
};
template <class TE, int UNR, int MT>
DI void thin_gemm(const bf16_t* A, int lda, const bf16_t* Bt, int K, int N, int ksplit, int nz, size_t zA, size_t zB, const TE& E, unsigned char* smem) {
    const int tid = tid_(), lane = tid & 63, w = tid >> 6, fr = lane & 15, fq = lane >> 4;
    const int ncg = N >> 6, nck = ncg * ksplit, nitems = nck * (4 / MT), kw = K / (ksplit * 8);
    float* red = (float*)smem;
    for (int item = blockIdx.x; item < nitems; item += gridDim.x) {
        const int cg = item % ncg, kg = (item / ncg) % ksplit, mh = (item / nck) * MT;
        const int k0 = kg * (K / ksplit) + w * kw;
        f32x4 tot[MT][4];
#pragma unroll
        for (int m = 0; m < MT; ++m)
#pragma unroll
            for (int n = 0; n < 4; ++n) tot[m][n] = (f32x4){0.f, 0.f, 0.f, 0.f};
#pragma unroll 1
        for (int z = 0; z < nz; ++z) {
            f32x4 acc[MT][4];
#pragma unroll
            for (int m = 0; m < MT; ++m)
#pragma unroll
                for (int n = 0; n < 4; ++n) acc[m][n] = (f32x4){0.f, 0.f, 0.f, 0.f};
            const bf16_t* Az = A + (size_t)z * zA + (size_t)(mh * 16 + fr) * lda + k0 + 8 * fq;
            const bf16_t* Bz = Bt + (size_t)z * zB + (size_t)(cg * 64 + fr) * K + k0 + 8 * fq;
#pragma unroll UNR
            for (int ks = 0; ks < kw; ks += 32) {
                bf16x8 af[MT], bfr[4];
#pragma unroll
                for (int m = 0; m < MT; ++m) af[m] = *(const bf16x8*)(Az + (size_t)(m * 16) * lda + ks);
#pragma unroll
                for (int n = 0; n < 4; ++n) bfr[n] = *(const bf16x8*)(Bz + (size_t)(n * 16) * K + ks);
#pragma unroll
                for (int m = 0; m < MT; ++m)
#pragma unroll
                    for (int n = 0; n < 4; ++n) acc[m][n] = MFMA16(bfr[n], af[m], acc[m][n]);
            }
#pragma unroll
            for (int m = 0; m < MT; ++m)
#pragma unroll
                for (int n = 0; n < 4; ++n) E.gate(z, mh + m, n, cg, fr, fq, acc[m][n], tot[m][n]);
        }
        __syncthreads();
#pragma unroll
        for (int m = 0; m < MT; ++m)
#pragma unroll
            for (int n = 0; n < 4; ++n) *(f32x4*)(red + ((w * 64 + m * 16 + fr) * 64 + n * 16 + 4 * fq)) = tot[m][n];
        __syncthreads();
#pragma unroll
        for (int i = 0; i < (MT + 1) / 2; ++i) { const int slot = tid + 512 * i; const int row = slot >> 4, c4 = (slot & 15) * 4;
            if (row < MT * 16) {
                f32x4 sres = {0.f, 0.f, 0.f, 0.f};
#pragma unroll
                for (int ww = 0; ww < 8; ++ww) sres += *(const f32x4*)(red + ((ww * 64 + row) * 64 + c4));
                E.store(mh * 16 + row, cg * 64 + c4, sres); } }
    }
    __syncthreads();
}

struct ConvJob { const float* src; bf16_t* dst; int pitch, col0, ncols, K, tile, split; };
DI void conv_load(const ConvJob& j, f32x4 (&v)[8], int tid) {
    const int nkt = j.K >> 6; const int kt = j.tile % nkt, nt = j.tile / nkt; const int k0 = kt * 64, n0 = nt * 256;
    const int nc = (tid & 63) * 4, kr = tid >> 6;
#pragma unroll
    for (int i = 0; i < 8; ++i) { const int k = k0 + kr + 8 * i;
        const int scol = j.split ? (nc < 128 ? 128 * nt + nc : 4096 + 128 * nt + nc - 128) : j.col0 + n0 + nc;
        v[i] = (n0 + nc < j.ncols) ? __builtin_nontemporal_load((const f32x4*)(j.src + (size_t)k * j.pitch + scol)) : (f32x4){0.f, 0.f, 0.f, 0.f}; }
}
DI void conv_store(const ConvJob& j, const f32x4 (&v)[8], float* tl, int tid) {
    const int nkt = j.K >> 6; const int kt = j.tile % nkt, nt = j.tile / nkt; const int k0 = kt * 64, n0 = nt * 256;
    const int nc = (tid & 63) * 4, kr = tid >> 6;
    __syncthreads();
#pragma unroll
    for (int i = 0; i < 8; ++i) *(f32x4*)(tl + (kr + 8 * i) * 260 + ((nc + 8 * i) & 255)) = v[i];
    __syncthreads();
#pragma unroll
    for (int i = 0; i < 4; ++i) { const int idx = tid + 512 * i; const int n = idx >> 3, kc = (idx & 7) * 8;
        float e[8];
#pragma unroll
        for (int jj = 0; jj < 8; ++jj) e[jj] = tl[(kc + jj) * 260 + ((n + kc) & 255)];
        u32x4 w; w.x = pack2(e[0], e[1]); w.y = pack2(e[2], e[3]); w.z = pack2(e[4], e[5]); w.w = pack2(e[6], e[7]);
        *(u32x4*)(j.dst + (size_t)(n0 + n) * j.K + k0 + kc) = w; }
}
DI ConvJob conv_job(const Params& p, int t) {
    const int l = t / TILES_PER_LAYER; const int u = t % TILES_PER_LAYER;
    const float* win = p.w_in + (size_t)l * 2048 * INC; bf16_t* wtin = p.Wt_in + (size_t)l * NIN * 2048;
    const size_t sq = (size_t)l * 2048 * 2048;
    ConvJob j; j.col0 = 0; j.K = 2048; j.split = 0;
    if (u < 512) { j.src = win; j.pitch = INC; j.ncols = 4096; j.dst = wtin; j.tile = u; j.split = 1; }
    else if (u < 768) { j.src = win; j.pitch = INC; j.col0 = 2048; j.ncols = 2048; j.dst = wtin + (size_t)4096 * 2048; j.tile = u - 512; }
    else if (u < 1920) { j.src = win; j.pitch = INC; j.col0 = 6144; j.ncols = 9216; j.dst = wtin + (size_t)6144 * 2048; j.tile = u - 768; }
    else if (u < 2688) { j.src = win; j.pitch = INC; j.col0 = 15392; j.ncols = 6144; j.dst = wtin + (size_t)15360 * 2048; j.tile = u - 1920; }
    else if (u < 2720) { j.src = win; j.pitch = INC; j.col0 = 15360; j.ncols = 32; j.dst = wtin + (size_t)21504 * 2048; j.tile = u - 2688; }
    else if (u < 2976) { j.src = p.w_cp + sq; j.pitch = 2048; j.ncols = 2048; j.dst = p.Wt_c + sq; j.tile = u - 2720; }
    else if (u < 3232) { j.src = p.w_ap + sq; j.pitch = 2048; j.ncols = 2048; j.dst = p.Wt_a + sq; j.tile = u - 2976; }
    else if (u < 3488) { j.src = p.w_mp + sq; j.pitch = 2048; j.ncols = 2048; j.dst = p.Wt_m + sq; j.tile = u - 3232; }
    else if (u < 3744) { j.src = p.w_out + sq; j.pitch = 2048; j.ncols = 2048; j.dst = p.Wt_o + sq; j.tile = u - 3488; }
    else if (u < 4768) { j.src = p.w1 + (size_t)l * 2048 * HID; j.pitch = HID; j.ncols = HID; j.dst = p.Wt1 + (size_t)l * 2048 * HID; j.tile = u - 3744; }
    else { j.src = p.w2 + (size_t)l * 2048 * HID; j.pitch = 2048; j.ncols = 2048; j.K = HID; j.dst = p.Wt2 + (size_t)l * 2048 * HID; j.tile = u - 4768; }
    return j;
}

DI void norm_row(const float* src, const float* g, bf16_t* xn_row, float* h_row, int lane) {
    f32x4 v[8]; float ss = 0.f;
#pragma unroll
    for (int i = 0; i < 8; ++i) { v[i] = *(const f32x4*)(src + (i * 64 + lane) * 4); ss += v[i][0] * v[i][0] + v[i][1] * v[i][1] + v[i][2] * v[i][2] + v[i][3] * v[i][3]; }
    ss = wave_sum(ss);
    const float r = rsqrtf(ss * (1.f / 2048.f) + 1e-6f);
#pragma unroll
    for (int i = 0; i < 8; ++i) { const f32x4 gg = *(const f32x4*)(g + (i * 64 + lane) * 4);
        u32x2 w; w.x = pack2(v[i][0] * r * gg[0], v[i][1] * r * gg[1]); w.y = pack2(v[i][2] * r * gg[2], v[i][3] * r * gg[3]);
        *(u32x2*)(xn_row + (i * 64 + lane) * 4) = w;
        if (h_row) *(f32x4*)(h_row + (i * 64 + lane) * 4) = v[i]; }
}

DI void phase0(const Params& p, unsigned char* smem) {
    const int G = gridDim.x, c = blockIdx.x, tid = threadIdx.x;
    float* tl = (float*)smem;
    {
        int t = (G % 8 == 0) ? (c % 8) * (G / 8) + c / 8 : c;
        ConvJob cur = conv_job(p, t < 2 * TILES_PER_LAYER ? t : 0);
        f32x4 va[8], vb[8];
        if (t < 2 * TILES_PER_LAYER) conv_load(cur, va, tid);
        while (t < 2 * TILES_PER_LAYER) {
            const int tn = t + G; const bool hn = tn < 2 * TILES_PER_LAYER;
            const ConvJob nxt = conv_job(p, hn ? tn : t);
            if (hn) conv_load(nxt, vb, tid);
            conv_store(cur, va, tl, tid);
#pragma unroll
            for (int i = 0; i < 8; ++i) va[i] = vb[i];
            cur = nxt; t = tn;
        }
    }
    const int gtid = c * 512 + tid, gstride = G * 512;
    for (int i = gtid; i < 2064 * 8; i += gstride) {
        const int pos = i >> 3, f = i & 7;
        const float invf = f == 0 ? 1.0f : f == 1 ? 0.1939227432012558f : f == 2 ? 0.03760603070259094f : f == 3 ? 0.007292664609849453f : f == 4 ? 0.0014142135623842478f
                         : f == 5 ? 0.00027424818836152554f : f == 6 ? 5.318296098266728e-05f : 1.0313386155758053e-05f;
        const float ang = (float)pos * invf;
        double a = (double)ang; const double k = rint(a * 0.15915494309189535); a -= k * 6.283185307179586;
        const double a2 = a * a;
        double ts = 1.0, tc = 1.0, sn = 1.0, cs = 1.0;
#pragma unroll 1
        for (int n = 1; n <= 14; ++n) { tc *= -a2 / (double)((2 * n - 1) * (2 * n)); ts *= -a2 / (double)((2 * n) * (2 * n + 1)); cs += tc; sn += ts; }
        sn *= a;
        p.ropec[i] = (float)cs; p.ropes[i] = (float)sn;
    }
    for (int i = gtid; i < (TP - TOK) * 2048 / 8; i += gstride) { const size_t o = (size_t)TOK * 2048 + (size_t)i * 8; const u32x4 z = {0u, 0u, 0u, 0u};
        *(u32x4*)(p.xn + o) = z; *(u32x4*)(p.yc + o) = z; *(u32x4*)(p.ya + o) = z; *(u32x4*)(p.ym + o) = z;
        *(f32x4*)(p.h + o) = (f32x4){0.f, 0.f, 0.f, 0.f}; *(f32x4*)(p.h + o + 4) = (f32x4){0.f, 0.f, 0.f, 0.f}; }
    const int lane = tid & 63, gw = (c * 512 + tid) >> 6, nw = G * 8;
    for (int r = gw; r < TOK; r += nw) {
        const float* src = r < META0 ? p.x + (size_t)r * 2048 : p.meta + (size_t)((r - META0) & 15) * 2048;
        norm_row(src, p.nmix, p.xn + (size_t)r * 2048, p.h + (size_t)r * 2048, lane);
    }
}

template <int R, bool OUT_F32>
DI void norm_rows(const Params& p, const float* g, int nrows) {
    const int tid = tid_(); const int lane = tid & 63, gw = (blockIdx.x * 512 + tid) >> 6, nw = gridDim.x * 8;
    for (int r0 = gw; r0 < nrows; r0 += R * nw) {
        f32x4 v[R][8]; float ss[R];
#pragma unroll
        for (int k = 0; k < R; ++k) { const int r = r0 + k * nw; const float* src = p.h + (size_t)(r < nrows ? r : r0) * 2048;
#pragma unroll
            for (int i = 0; i < 8; ++i) v[k][i] = *(const f32x4*)(src + (i * 64 + lane) * 4); }
#pragma unroll
        for (int k = 0; k < R; ++k) { float a = 0.f;
#pragma unroll
            for (int i = 0; i < 8; ++i) a += v[k][i][0] * v[k][i][0] + v[k][i][1] * v[k][i][1] + v[k][i][2] * v[k][i][2] + v[k][i][3] * v[k][i][3];
            ss[k] = rsqrtf(wave_sum(a) * (1.f / 2048.f) + 1e-6f); }
#pragma unroll
        for (int i = 0; i < 8; ++i) { const f32x4 gg = *(const f32x4*)(g + (i * 64 + lane) * 4);
#pragma unroll
            for (int k = 0; k < R; ++k) { const int r = r0 + k * nw;
                if (r < nrows) { const f32x4 y = v[k][i] * ss[k] * gg;
                    if (OUT_F32) *(f32x4*)(p.out + (size_t)r * 2048 + (i * 64 + lane) * 4) = y;
                    else { u32x2 w; w.x = pack2(y[0], y[1]); w.y = pack2(y[2], y[3]); *(u32x2*)(p.xn + (size_t)r * 2048 + (i * 64 + lane) * 4) = w; } } } }
    }
}
DI void norm_phase(const Params& p, const float* g) { norm_rows<2, false>(p, g, TOK); }
DI void final_phase(const Params& p) { norm_rows<2, true>(p, p.fnorm, META0); }

typedef short s16x4 __attribute__((ext_vector_type(4)));
DI u32x2 trread(const bf16_t* T, int pitch, int row0, int col0, int lane) {
    const int q = (lane & 15) >> 2, pp = lane & 3;
    const s16x4 v = __builtin_amdgcn_ds_read_tr16_b64_v4i16((LAS s16x4*)(T + (row0 + q) * pitch + col0 + 4 * pp));
    return __builtin_bit_cast(u32x2, v);
}
DI bf16x8 join8(u32x2 lo, u32x2 hi) { u32x4 w; w.x = lo.x; w.y = lo.y; w.z = hi.x; w.w = hi.y; return __builtin_bit_cast(bf16x8, w); }

DI void mlstm_chain(const Params& p, int l, int item, unsigned char* smem) {
    const int tid = tid_(), lane = tid & 63, w = tid >> 6, fr = lane & 15, fq = lane >> 4;
    const int b = item >> 6, hh = (item >> 3) & 7, dir = (item >> 2) & 1, sl = item & 3;
    bf16_t* Qs = (bf16_t*)smem; bf16_t* Ks = Qs + 128 * 136; bf16_t* Vs = Ks + 128 * 136; bf16_t* CTs = Vs + 128 * 72;
    float* gA = (float*)(CTs + 64 * 136); float* gPM = gA + 17 * 128; float* gBC = gPM + 17 * 128; float* gW = gBC + 17 * 128; float* nvec = gW + 128;
    const float bi = p.mbi[l * 16 + dir * 8 + hh], bff = p.mbf[l * 16 + dir * 8 + hh];
    const float* gt = p.gt; const bf16_t* P = p.P;
    bf16_t* hout = (bf16_t*)p.hm + (size_t)dir * TP * 2048;
    auto rowOf = [&](int c, int tau) -> int {
        if (dir == 0) { if (c == 0) return tau >= 112 ? META0 + b * 16 + (tau - 112) : -1; return b * 2048 + (c - 1) * 128 + tau; }
        if (c == 16) return tau < 16 ? META0 + b * 16 + (15 - tau) : -1;
        return b * 2048 + (15 - c) * 128 + (127 - tau);
    };
    for (int i = tid; i < 64 * 136 / 2; i += 512) ((unsigned*)CTs)[i] = 0u;
    if (tid < 128) nvec[tid] = 0.f;
    for (int c = w; c < 17; c += 8) {
        float li[2], lf[2];
#pragma unroll
        for (int e = 0; e < 2; ++e) { const int r = rowOf(c, 2 * lane + e);
            if (r >= 0) { const float gi = gt[(size_t)r * 32 + dir * 16 + hh], gf = gt[(size_t)r * 32 + dir * 16 + 8 + hh];
                li[e] = gi + bi; const float xf = gf + bff; lf[e] = fminf(xf, 0.f) - log1pf(__expf(-fabsf(xf))); }
            else { li[e] = -1e30f; lf[e] = 0.f; } }
        float ps = lf[0] + lf[1];
#pragma unroll
        for (int o = 1; o < 64; o <<= 1) { const float t = __shfl_up(ps, o); if (lane >= o) ps += t; }
        const float bc1 = ps, bc0 = ps - lf[1];
        const float A0 = li[0] - bc0, A1 = li[1] - bc1;
        float pmx = fmaxf(A0, A1);
#pragma unroll
        for (int o = 1; o < 64; o <<= 1) { const float t = __shfl_up(pmx, o); if (lane >= o) pmx = fmaxf(pmx, t); }
        float prev = __shfl_up(pmx, 1); if (lane == 0) prev = -3e38f;
        gA[c * 128 + 2 * lane] = A0; gA[c * 128 + 2 * lane + 1] = A1; gPM[c * 128 + 2 * lane] = fmaxf(prev, A0); gPM[c * 128 + 2 * lane + 1] = pmx;
        gBC[c * 128 + 2 * lane] = bc0; gBC[c * 128 + 2 * lane + 1] = bc1;
    }
    f32x4 cacc[4]; f32x4 nacc = {0.f, 0.f, 0.f, 0.f};
#pragma unroll
    for (int e = 0; e < 4; ++e) cacc[e] = (f32x4){0.f, 0.f, 0.f, 0.f};
    float m_st = 0.f;
    const float scale = 0.08838834764831845f;
    bf16x8 ones;
#pragma unroll
    for (int i = 0; i < 8; ++i) ones[i] = (short)0x3F80;
    u32x4 pq[4], pk[4], pv[2];
    auto fetch = [&](int c) {
#pragma unroll
        for (int i = 0; i < 4; ++i) { const int idx = tid + 512 * i; const int tau = idx >> 4, ch = idx & 15; const int r = rowOf(c, tau);
            pq[i] = (u32x4){0u, 0u, 0u, 0u}; pk[i] = (u32x4){0u, 0u, 0u, 0u};
            if (r >= 0) { pq[i] = *(const u32x4*)(P + (size_t)r * PC + oMQ + hh * 128 + ch * 8); pk[i] = *(const u32x4*)(P + (size_t)r * PC + oMK + hh * 128 + ch * 8); } }
#pragma unroll
        for (int i = 0; i < 2; ++i) { const int idx = tid + 512 * i; const int tau = idx >> 3, ch = idx & 7; const int r = rowOf(c, tau);
            pv[i] = (u32x4){0u, 0u, 0u, 0u};
            if (r >= 0) pv[i] = *(const u32x4*)(P + (size_t)r * PC + oMV + hh * 256 + sl * 64 + ch * 8); }
    };
    fetch(0);
    __syncthreads();
    for (int c = 0; c < 17; ++c) {
        const float* cA = gA + c * 128; const float* cPM = gPM + c * 128; const float* cBC = gBC + c * 128;
        const float Mend = fmaxf(m_st, cPM[127]); const float total = cBC[127];
#pragma unroll
        for (int i = 0; i < 4; ++i) { const int idx = tid + 512 * i; const int tau = idx >> 4, ch = idx & 15;
            *(u32x4*)(Qs + tau * 136 + ch * 8) = pq[i]; *(u32x4*)(Ks + tau * 136 + ch * 8) = pk[i]; }
#pragma unroll
        for (int i = 0; i < 2; ++i) { const int idx = tid + 512 * i; const int tau = idx >> 3, ch = idx & 7; *(u32x4*)(Vs + tau * 72 + ch * 8) = pv[i]; }
        if (tid < 128) gW[tid] = __expf(fminf(cA[tid] - Mend, 0.f)) * scale;
        __syncthreads();
        if (c + 1 < 17) fetch(c + 1);
        {
            const int tt = 16 * w + fr;
            const float Mt = fmaxf(m_st, cPM[tt]); const float a_t = __expf(m_st - Mt);
            bf16x8 qf[4];
#pragma unroll
            for (int kk = 0; kk < 4; ++kk) qf[kk] = *(const bf16x8*)(Qs + tt * 136 + 32 * kk + 8 * fq);
            f32x4 acc[4];
#pragma unroll
            for (int et = 0; et < 4; ++et) { acc[et] = (f32x4){0.f, 0.f, 0.f, 0.f};
#pragma unroll
                for (int kk = 0; kk < 4; ++kk) { const bf16x8 cf = *(const bf16x8*)(CTs + (16 * et + fr) * 136 + 32 * kk + 8 * fq); acc[et] = MFMA16(cf, qf[kk], acc[et]); }
                acc[et] *= a_t; }
            float qn = 0.f;
#pragma unroll
            for (int kk = 0; kk < 4; ++kk)
#pragma unroll
                for (int i = 0; i < 8; ++i) qn += bf2f(qf[kk][i]) * nvec[32 * kk + 8 * fq + i];
            float rs = 0.f;
            for (int kp = 0; kp <= (w >> 1); ++kp) {
                f32x4 s0 = {0.f, 0.f, 0.f, 0.f}, s1 = {0.f, 0.f, 0.f, 0.f};
#pragma unroll
                for (int kk = 0; kk < 4; ++kk) { const bf16x8 kf = *(const bf16x8*)(Ks + (32 * kp + fr) * 136 + 32 * kk + 8 * fq); s0 = MFMA16(kf, qf[kk], s0); }
                if (2 * kp + 1 <= w) {
#pragma unroll
                    for (int kk = 0; kk < 4; ++kk) { const bf16x8 kf = *(const bf16x8*)(Ks + (32 * kp + 16 + fr) * 136 + 32 * kk + 8 * fq); s1 = MFMA16(kf, qf[kk], s1); }
                }
                float pvv[8];
                const f32x4 ga0 = *(const f32x4*)(cA + 32 * kp + 4 * fq), ga1 = *(const f32x4*)(cA + 32 * kp + 16 + 4 * fq);
#pragma unroll
                for (int j = 0; j < 4; ++j) { const int sx = 32 * kp + 4 * fq + j; float wv = __expf(fminf(ga0[j] - Mt, 0.f)) * scale; wv = (sx <= tt) ? wv : 0.f; pvv[j] = s0[j] * wv; rs += pvv[j]; }
#pragma unroll
                for (int j = 0; j < 4; ++j) { const int sx = 32 * kp + 16 + 4 * fq + j; float wv = __expf(fminf(ga1[j] - Mt, 0.f)) * scale; wv = (sx <= tt) ? wv : 0.f; pvv[4 + j] = s1[j] * wv; rs += pvv[4 + j]; }
                u32x4 pw; pw.x = pack2(pvv[0], pvv[1]); pw.y = pack2(pvv[2], pvv[3]); pw.z = pack2(pvv[4], pvv[5]); pw.w = pack2(pvv[6], pvv[7]);
                const bf16x8 pf = __builtin_bit_cast(bf16x8, pw);
#pragma unroll
                for (int et = 0; et < 4; ++et) { const bf16x8 vf = join8(trread(Vs, 72, 32 * kp + 4 * fq, 16 * et, lane), trread(Vs, 72, 32 * kp + 16 + 4 * fq, 16 * et, lane));
                    acc[et] = MFMA16(vf, pf, acc[et]); }
            }
            rs += __shfl_xor(rs, 16); rs += __shfl_xor(rs, 32); qn += __shfl_xor(qn, 16); qn += __shfl_xor(qn, 32);
            float den = rs + a_t * qn; den = fmaxf(fabsf(den), __expf(-(cBC[tt] + Mt)));
            const float inv = 1.f / den;
            const int r = rowOf(c, tt);
            if (r >= 0) {
#pragma unroll
                for (int et = 0; et < 4; ++et) { const f32x4 o = acc[et] * inv; u32x2 ow; ow.x = pack2(o[0], o[1]); ow.y = pack2(o[2], o[3]); *(u32x2*)(hout + (size_t)r * 2048 + hh * 256 + sl * 64 + 16 * et + 4 * fq) = ow; }
            }
        }
        {
            const float decay = __expf(m_st - Mend);
#pragma unroll
            for (int et = 0; et < 4; ++et) cacc[et] *= decay;
            nacc *= decay;
#pragma unroll
            for (int kk = 0; kk < 4; ++kk) {
                const u32x2 klo = trread(Ks, 136, 32 * kk + 8 * fq, 16 * w, lane), khi = trread(Ks, 136, 32 * kk + 8 * fq + 4, 16 * w, lane);
                const f32x4 w0 = *(const f32x4*)(gW + 32 * kk + 8 * fq), w1 = *(const f32x4*)(gW + 32 * kk + 8 * fq + 4);
                u32x4 kw; kw.x = pack2(bf_lo(klo.x) * w0[0], bf_hi(klo.x) * w0[1]); kw.y = pack2(bf_lo(klo.y) * w0[2], bf_hi(klo.y) * w0[3]);
                kw.z = pack2(bf_lo(khi.x) * w1[0], bf_hi(khi.x) * w1[1]); kw.w = pack2(bf_lo(khi.y) * w1[2], bf_hi(khi.y) * w1[3]);
                const bf16x8 kt = __builtin_bit_cast(bf16x8, kw);
                nacc = MFMA16(kt, ones, nacc);
#pragma unroll
                for (int et = 0; et < 4; ++et) { const bf16x8 vt = join8(trread(Vs, 72, 32 * kk + 8 * fq, 16 * et, lane), trread(Vs, 72, 32 * kk + 8 * fq + 4, 16 * et, lane)); cacc[et] = MFMA16(kt, vt, cacc[et]); } }
        }
        __syncthreads();
#pragma unroll
        for (int et = 0; et < 4; ++et) { u32x2 cw; cw.x = pack2(cacc[et][0], cacc[et][1]); cw.y = pack2(cacc[et][2], cacc[et][3]); *(u32x2*)(CTs + (16 * et + fr) * 136 + 16 * w + 4 * fq) = cw; }
        if (fr == 0) *(f32x4*)(nvec + 16 * w + 4 * fq) = nacc;
        m_st = total + Mend;
    }
    __syncthreads();
}

DI u32x4 rope8(u32x4 self, u32x4 other, int ch, const float* cs, const float* sn, float mul) {
    const float sgn = ch == 0 ? -1.f : 1.f;
    const f32x4 c0 = *(const f32x4*)cs, c1 = *(const f32x4*)(cs + 4), s0 = *(const f32x4*)sn, s1 = *(const f32x4*)(sn + 4);
    u32x4 o;
    o.x = pack2((bf_lo(self.x) * c0[0] + sgn * bf_lo(other.x) * s0[0]) * mul, (bf_hi(self.x) * c0[1] + sgn * bf_hi(other.x) * s0[1]) * mul);
    o.y = pack2((bf_lo(self.y) * c0[2] + sgn * bf_lo(other.y) * s0[2]) * mul, (bf_hi(self.y) * c0[3] + sgn * bf_hi(other.y) * s0[3]) * mul);
    o.z = pack2((bf_lo(self.z) * c1[0] + sgn * bf_lo(other.z) * s1[0]) * mul, (bf_hi(self.z) * c1[1] + sgn * bf_hi(other.z) * s1[1]) * mul);
    o.w = pack2((bf_lo(self.w) * c1[2] + sgn * bf_lo(other.w) * s1[2]) * mul, (bf_hi(self.w) * c1[3] + sgn * bf_hi(other.w) * s1[3]) * mul);
    return o;
}
DI u32x4 scale8(u32x4 v, float mul) {
    u32x4 o; o.x = pack2(bf_lo(v.x) * mul, bf_hi(v.x) * mul); o.y = pack2(bf_lo(v.y) * mul, bf_hi(v.y) * mul); o.z = pack2(bf_lo(v.z) * mul, bf_hi(v.z) * mul); o.w = pack2(bf_lo(v.w) * mul, bf_hi(v.w) * mul);
    return o;
}

DI void attn_item(const Params& p, int l, int it, unsigned char* smem) {
    const int tid = tid_(), lane = tid & 63, w = tid >> 6, fr = lane & 15, fq = lane >> 4;
    bf16_t* Ks = (bf16_t*)smem;
    bf16_t* Vs = Ks + 416 * 72;
    const bf16_t* P = p.P;
    int b, kvh, j, meta;
    if (it < 512) { b = it >> 7; kvh = (it >> 4) & 7; j = it & 15; meta = 0; } else { const int x = it - 512; b = x >> 3; kvh = x & 7; j = 0; meta = 1; }
    const int r_begin = meta ? 0 : (j == 0 ? 128 : 0);
    const int r_end = meta ? 128 : (j == 15 ? 256 : 384);
    const int kbase = meta ? 0 : (j - 1) * 128;
    const int nslots = 16 + r_end - r_begin; const int nsteps = (nslots + 31) >> 5; const int nrows = nsteps * 32;
    {
        u32x4 kv[7], vv[7], ov[7];
#pragma unroll
        for (int i = 0; i < 7; ++i) { const int idx = tid + 512 * i; const int slot = idx >> 3, ch = idx & 7;
            kv[i] = (u32x4){0u, 0u, 0u, 0u}; vv[i] = kv[i]; ov[i] = kv[i];
            if (slot < nslots) { const int row = slot < 16 ? META0 + b * 16 + slot : b * 2048 + kbase + r_begin + slot - 16;
                const bf16_t* kp = P + (size_t)row * PC + oAK + kvh * 64;
                kv[i] = *(const u32x4*)(kp + ch * 8); vv[i] = *(const u32x4*)(P + (size_t)row * PC + oAV + kvh * 64 + ch * 8);
                if (ch < 2) ov[i] = *(const u32x4*)(kp + (ch ^ 1) * 8); } }
#pragma unroll
        for (int i = 0; i < 7; ++i) { const int idx = tid + 512 * i; const int slot = idx >> 3, ch = idx & 7;
            if (idx < nrows * 8) {
                u32x4 kk = kv[i];
                if (slot < nslots && ch < 2) { const int pos = slot < 16 ? slot : 16 + kbase + r_begin + slot - 16; kk = rope8(kk, ov[i], ch, p.ropec + pos * 8, p.ropes + pos * 8, 1.f); }
                *(u32x4*)(Ks + slot * 72 + ch * 8) = kk; *(u32x4*)(Vs + slot * 72 + ch * 8) = vv[i]; } }
    }
    const int nq = meta ? (w < 4 ? 1 : 0) : 4;
    const int A0 = 16 * w;
    int qlo, qhi, qrow;
    { int pos;
      if (!meta) { const int a = A0 + fr; qrow = b * 2048 + j * 128 + a; pos = 16 + j * 128 + a; qlo = a; qhi = a + 256; }
      else { qrow = META0 + b * 16 + fr; pos = fr; qlo = -1; qhi = 112 + fr; }
      (void)pos; }
    const int qpos = meta ? fr : 16 + j * 128 + A0 + fr;
    const unsigned qspan = (unsigned)(qhi - qlo);
    bf16x8 qf[4][2]; float skv[4];
#pragma unroll
    for (int qt = 0; qt < 4; ++qt) { qf[qt][0] = qf[qt][1] = (bf16x8){0, 0, 0, 0, 0, 0, 0, 0}; skv[qt] = 0.f;
        if (qt < nq) { const int head = kvh * 4 + (meta ? w : qt);
            skv[qt] = p.sink[l * 32 + head];
            const bf16_t* qp = P + (size_t)qrow * PC + oAQ + head * 64;
            u32x4 q0 = *(const u32x4*)(qp + 8 * fq); u32x4 q1 = *(const u32x4*)(qp + 32 + 8 * fq);
            if (fq < 2) { const u32x4 ov = *(const u32x4*)(qp + 8 * (fq ^ 1)); q0 = rope8(q0, ov, fq, p.ropec + qpos * 8, p.ropes + qpos * 8, 0.125f); } else q0 = scale8(q0, 0.125f);
            q1 = scale8(q1, 0.125f);
            qf[qt][0] = __builtin_bit_cast(bf16x8, q0); qf[qt][1] = __builtin_bit_cast(bf16x8, q1); } }
    float mrun[4], lrun[4];
#pragma unroll
    for (int qt = 0; qt < 4; ++qt) { mrun[qt] = -1e30f; lrun[qt] = 0.f; }
    __syncthreads();
    auto step_mode = [&](int st) -> int {
        if (meta || st == 0) return 2;
        const int R0 = r_begin + 32 * st - 16, R1 = R0 + 31;
        if (R1 < A0 || R0 > A0 + 15 + 256) return 0;
        if (R0 >= A0 + 15 && R1 <= A0 + 256 && 32 * st + 31 < nslots) return 1;
        return 2;
    };
#define ATT_PEN(st, pen) do { _Pragma("unroll") for (int e_ = 0; e_ < 8; ++e_) { const int slot_ = 32 * (st) + 16 * (e_ >> 2) + 4 * fq + (e_ & 3); const int r_ = r_begin + slot_ - 16; \
        const bool vis_ = (slot_ < 16) || (slot_ < nslots && (unsigned)(r_ - qlo) <= qspan); pen[e_] = vis_ ? 0.f : -1e30f; } } while (0)
#define ATT_S4(s0, s1) do { \
        _Pragma("unroll") for (int q_ = 0; q_ < 4; ++q_) { s0[q_] = (f32x4){0.f, 0.f, 0.f, 0.f}; s1[q_] = (f32x4){0.f, 0.f, 0.f, 0.f}; } \
        _Pragma("unroll") for (int q_ = 0; q_ < 4; ++q_) if (q_ < nq) s0[q_] = MFMA16(kf[0][0], qf[q_][0], s0[q_]); \
        _Pragma("unroll") for (int q_ = 0; q_ < 4; ++q_) if (q_ < nq) s1[q_] = MFMA16(kf[1][0], qf[q_][0], s1[q_]); \
        _Pragma("unroll") for (int q_ = 0; q_ < 4; ++q_) if (q_ < nq) s0[q_] = MFMA16(kf[0][1], qf[q_][1], s0[q_]); \
        _Pragma("unroll") for (int q_ = 0; q_ < 4; ++q_) if (q_ < nq) s1[q_] = MFMA16(kf[1][1], qf[q_][1], s1[q_]); } while (0)
    for (int st = 0; st < nsteps; ++st) {
        const int mode = step_mode(st);
        if (mode == 0) continue;
        bf16x8 kf[2][2];
#pragma unroll
        for (int tl = 0; tl < 2; ++tl)
#pragma unroll
            for (int kk = 0; kk < 2; ++kk) kf[tl][kk] = *(const bf16x8*)(Ks + (32 * st + 16 * tl + fr) * 72 + 32 * kk + 8 * fq);
        float pen[8];
        if (mode == 2) ATT_PEN(st, pen); else {
#pragma unroll
            for (int e = 0; e < 8; ++e) pen[e] = 0.f; }
        f32x4 s0[4], s1[4];
        ATT_S4(s0, s1);
#pragma unroll
        for (int qt = 0; qt < 4; ++qt) {
            if (qt < nq) { float sv[8];
#pragma unroll
                for (int e = 0; e < 8; ++e) { float v = (e >> 2) ? s1[qt][e & 3] : s0[qt][e & 3]; if (mode == 2) v += pen[e]; sv[e] = v; }
                mrun[qt] = fmaxf(mrun[qt], fmaxf(fmaxf(fmaxf(sv[0], sv[1]), fmaxf(sv[2], sv[3])), fmaxf(fmaxf(sv[4], sv[5]), fmaxf(sv[6], sv[7])))); }
        }
    }
#pragma unroll
    for (int qt = 0; qt < 4; ++qt) { float m = mrun[qt]; m = fmaxf(m, __shfl_xor(m, 16)); m = fmaxf(m, __shfl_xor(m, 32)); mrun[qt] = fmaxf(m, skv[qt]); }
    f32x4 O[4][4];
#pragma unroll
    for (int qt = 0; qt < 4; ++qt)
#pragma unroll
        for (int dt = 0; dt < 4; ++dt) O[qt][dt] = (f32x4){0.f, 0.f, 0.f, 0.f};
    for (int st = 0; st < nsteps; ++st) {
        const int mode = step_mode(st);
        if (mode == 0) continue;
        bf16x8 kf[2][2], vf[4];
#pragma unroll
        for (int tl = 0; tl < 2; ++tl)
#pragma unroll
            for (int kk = 0; kk < 2; ++kk) kf[tl][kk] = *(const bf16x8*)(Ks + (32 * st + 16 * tl + fr) * 72 + 32 * kk + 8 * fq);
#pragma unroll
        for (int dt = 0; dt < 4; ++dt) vf[dt] = join8(trread(Vs, 72, 32 * st + 4 * fq, 16 * dt, lane), trread(Vs, 72, 32 * st + 16 + 4 * fq, 16 * dt, lane));
        float pen[8];
        if (mode == 2) ATT_PEN(st, pen); else {
#pragma unroll
            for (int e = 0; e < 8; ++e) pen[e] = 0.f; }
        f32x4 s0[4], s1[4];
        ATT_S4(s0, s1);
        bf16x8 pf[4];
#pragma unroll
        for (int qt = 0; qt < 4; ++qt) {
            pf[qt] = (bf16x8){0, 0, 0, 0, 0, 0, 0, 0};
            if (qt < nq) { float ps = 0.f; float pv[8];
#pragma unroll
                for (int e = 0; e < 8; ++e) { float v = (e >> 2) ? s1[qt][e & 3] : s0[qt][e & 3]; if (mode == 2) v += pen[e]; pv[e] = __expf(v - mrun[qt]); ps += pv[e]; }
                lrun[qt] += ps;
                u32x4 pw; pw.x = pack2(pv[0], pv[1]); pw.y = pack2(pv[2], pv[3]); pw.z = pack2(pv[4], pv[5]); pw.w = pack2(pv[6], pv[7]);
                pf[qt] = __builtin_bit_cast(bf16x8, pw); }
        }
#pragma unroll
        for (int dt = 0; dt < 4; ++dt)
#pragma unroll
            for (int qt = 0; qt < 4; ++qt)
                if (qt < nq) O[qt][dt] = MFMA16(vf[dt], pf[qt], O[qt][dt]);
    }
#undef ATT_S4
#undef ATT_PEN
#pragma unroll
    for (int qt = 0; qt < 4; ++qt) {
        if (qt < nq) {
            const int head = kvh * 4 + (meta ? w : qt);
            float ls = lrun[qt]; ls += __shfl_xor(ls, 16); ls += __shfl_xor(ls, 32);
            const float sc = 1.f / (ls + __expf(skv[qt] - mrun[qt]));
#pragma unroll
            for (int dt = 0; dt < 4; ++dt) { const f32x4 o = O[qt][dt] * sc; u32x2 ow; ow.x = pack2(o[0], o[1]); ow.y = pack2(o[2], o[3]);
                *(u32x2*)(p.ya + (size_t)qrow * 2048 + head * 64 + 16 * dt + 4 * fq) = ow; }
        }
    }
    __syncthreads();
}

DI void mixer_post(const Params& p, int l) {
    const int tid = tid_(), lane = tid & 63;
    const int gw = (blockIdx.x * 512 + tid) >> 6, nw = gridDim.x * 8;
    const bf16_t* hm0 = (const bf16_t*)p.hm; const bf16_t* hm1 = hm0 + (size_t)TP * 2048;
    for (int row = gw; row < TOK; row += nw) {
        f32x4 v[8]; u32x2 ob[8];
#pragma unroll
        for (int hh = 0; hh < 8; ++hh) { const int col = hh * 256 + lane * 4;
            { const u32x2 a = *(const u32x2*)(hm0 + (size_t)row * 2048 + col), b2 = *(const u32x2*)(hm1 + (size_t)row * 2048 + col);
              v[hh] = (f32x4){bf_lo(a.x) + bf_lo(b2.x), bf_hi(a.x) + bf_hi(b2.x), bf_lo(a.y) + bf_lo(b2.y), bf_hi(a.y) + bf_hi(b2.y)}; }
            ob[hh] = *(const u32x2*)(p.P + (size_t)row * PC + oMO + col); }
#pragma unroll
        for (int hh = 0; hh < 8; ++hh) { const int col = hh * 256 + lane * 4;
            float ss = v[hh][0] * v[hh][0] + v[hh][1] * v[hh][1] + v[hh][2] * v[hh][2] + v[hh][3] * v[hh][3]; ss = wave_sum(ss);
            const float r = rsqrtf(ss * (1.f / 256.f) + 1e-6f);
            const f32x4 gn = *(const f32x4*)(p.gain + (size_t)l * 2048 + col);
            u32x2 ow; ow.x = pack2(v[hh][0] * r * gn[0] * sigmoidf_(bf_lo(ob[hh].x)), v[hh][1] * r * gn[1] * sigmoidf_(bf_hi(ob[hh].x)));
            ow.y = pack2(v[hh][2] * r * gn[2] * sigmoidf_(bf_lo(ob[hh].y)), v[hh][3] * r * gn[3] * sigmoidf_(bf_hi(ob[hh].y)));
            *(u32x2*)(p.ym + (size_t)row * 2048 + col) = ow; }
    }
    const int gtid = blockIdx.x * 512 + tid, gstride = gridDim.x * 512;
    const float* cw = p.conv_w + (size_t)l * 3 * 2048; const float* cb = p.conv_b + (size_t)l * 2048;
    for (int idx = gtid; idx < TOK * 256; idx += gstride) { const int row = idx >> 8, c0 = (idx & 255) * 8;
        int prow, nrow;
        if (row < META0) { const int bb = row >> 11, s = row & 2047; prow = s == 0 ? META0 + bb * 16 + 15 : row - 1; nrow = s == 2047 ? -1 : row + 1; }
        else { const int bb = (row - META0) >> 4, m = (row - META0) & 15; prow = m == 0 ? -1 : row - 1; nrow = m == 15 ? bb * 2048 : row + 1; }
        const bf16_t* pr = p.P + (size_t)row * PC + c0;
        const u32x4 x1 = *(const u32x4*)(pr + oCX), b1 = *(const u32x4*)(pr + oCB);
        u32x4 xp = {0u, 0u, 0u, 0u}, xq = xp;
        if (prow >= 0) xp = *(const u32x4*)(p.P + (size_t)prow * PC + c0 + oCX);
        if (nrow >= 0) xq = *(const u32x4*)(p.P + (size_t)nrow * PC + c0 + oCX);
        const f32x4 w0a = *(const f32x4*)(cw + c0), w0b = *(const f32x4*)(cw + c0 + 4), w1a = *(const f32x4*)(cw + 2048 + c0), w1b = *(const f32x4*)(cw + 2048 + c0 + 4);
        const f32x4 w2a = *(const f32x4*)(cw + 4096 + c0), w2b = *(const f32x4*)(cw + 4096 + c0 + 4), ba = *(const f32x4*)(cb + c0), bbv = *(const f32x4*)(cb + c0 + 4);
        u32x4 o;
#pragma unroll
        for (int k = 0; k < 4; ++k) {
            const float w0l = k < 2 ? w0a[2 * k] : w0b[2 * k - 4], w0h = k < 2 ? w0a[2 * k + 1] : w0b[2 * k - 3];
            const float w1l = k < 2 ? w1a[2 * k] : w1b[2 * k - 4], w1h = k < 2 ? w1a[2 * k + 1] : w1b[2 * k - 3];
            const float w2l = k < 2 ? w2a[2 * k] : w2b[2 * k - 4], w2h = k < 2 ? w2a[2 * k + 1] : w2b[2 * k - 3];
            const float bl = k < 2 ? ba[2 * k] : bbv[2 * k - 4], bh = k < 2 ? ba[2 * k + 1] : bbv[2 * k - 3];
            const float ul = bf_lo(x1[k]), uh = bf_hi(x1[k]);
            const float pl = bf_lo(xp[k]), ph = bf_hi(xp[k]);
            const float nl = bf_lo(xq[k]), nh = bf_hi(xq[k]);
            const float yl = bf_lo(b1[k]) * (pl * w0l + ul * w1l + nl * w2l + bl), yh = bf_hi(b1[k]) * (ph * w0h + uh * w1h + nh * w2h + bh);
            o[k] = pack2(yl, yh);
        }
        *(u32x4*)(p.yc + (size_t)row * 2048 + c0) = o; }
}

__global__ void __launch_bounds__(512, 2) fwd_megakernel(Params p) {
    extern __shared__ __attribute__((aligned(16))) unsigned char smem[];
    cg::grid_group grid = cg::this_grid();
    LAS unsigned char* lds = (LAS unsigned char*)smem;
    const int G = gridDim.x, c = blockIdx.x;
    volatile LAS unsigned* xst = (volatile LAS unsigned*)(lds + LDS_BYTES - 16);
    if (threadIdx.x < 4) xst[threadIdx.x] = 0u;
    __syncthreads();
    const XcdBarrier xb = xcd_barrier_post(p.bar, xst);
    phase0(p, smem);
    if (p.out == nullptr) grid.sync();
    xcd_barrier(xb);
    for (int l = 0; l < 2; ++l) {
        if (l > 0) { norm_phase(p, p.nmix + (size_t)l * 2048); xcd_barrier(xb); }
        {
            pg8::Sched S; S.init(TP, NIN, 2048, G, c, 1); S.A0 = (const char*)p.xn; S.B0 = (const char*)(p.Wt_in + (size_t)l * NIN * 2048);
            EpiIn E; E.P = p.P; E.G = p.G; E.gt = p.gt; E.bgate = p.b_gate + (size_t)l * GC;
            pg8::gemm_phase<EpiIn>(lds, 2048, S, E);
        }
        xcd_barrier(xb);
        const int cx = (G % 8 == 0) ? (c % 8) * (G / 8) + c / 8 : c;
        for (int it = cx; it < 256; it += G) mlstm_chain(p, l, it, smem);
        for (int it = cx; it < (l == 1 ? 512 : 544); it += G) attn_item(p, l, it, smem);
        xcd_barrier(xb);
        constexpr int MR = META0;
        mixer_post(p, l);
        xcd_barrier(xb);
        {
            const size_t sq = (size_t)l * 2048 * 2048;
            pg8::Sched S; S.init(MR, 2048, 2048, G, c, 3); S.A0 = (const char*)p.yc; S.zA = (size_t)TP * 2048 * 2;
            S.B0 = (const char*)(p.Wt_c + sq); S.zB = (size_t)2 * 2048 * 2048 * 2;
            EpiBr E; E.G = p.G; E.mg = p.mg;
            pg8::gemm_phase<EpiBr>(lds, 2048, S, E);
            if (l == 0) { ThinBr T; T.G = p.G; T.mg = p.mg; thin_gemm<ThinBr, 4, 1>(p.yc + (size_t)META0 * 2048, 2048, p.Wt_c + sq, 2048, 2048, 1, 3, (size_t)TP * 2048, (size_t)2 * 2048 * 2048, T, smem); }
        }
        xcd_barrier(xb);
        {
            pg8::Sched S; S.init(MR, 2048, 2048, G, c, 1); S.A0 = (const char*)p.mg; S.B0 = (const char*)(p.Wt_o + (size_t)l * 2048 * 2048);
            EpiRes E; E.h = p.h;
            pg8::gemm_phase<EpiRes>(lds, 2048, S, E);
            if (l == 0) { ThinRes T; T.h = p.h; thin_gemm<ThinRes, 2, 4>(p.mg + (size_t)META0 * 2048, 2048, p.Wt_o, 2048, 2048, 2, 1, 0, 0, T, smem); }
        }
        xcd_barrier(xb);
        norm_phase(p, p.nmlp + (size_t)l * 2048);
        xcd_barrier(xb);
        {
            pg8::Sched S; S.init(MR, HID, 2048, G, c, 1); S.A0 = (const char*)p.xn; S.B0 = (const char*)(p.Wt1 + (size_t)l * 2048 * HID);
            EpiUp E; E.act = p.P;
            pg8::gemm_phase<EpiUp>(lds, 2048, S, E);
            if (l == 0) { ThinUp T; T.act = p.P; thin_gemm<ThinUp, 2, 4>(p.xn + (size_t)META0 * 2048, 2048, p.Wt1, 2048, HID, 1, 1, 0, 0, T, smem); }
        }
        xcd_barrier(xb);
        {
            pg8::Sched S; S.init(MR, 2048, HID, G, c, 1); S.A0 = (const char*)p.P; S.B0 = (const char*)(p.Wt2 + (size_t)l * 2048 * HID);
            EpiRes E; E.h = p.h;
            pg8::gemm_phase<EpiRes>(lds, HID, S, E);
            if (l == 0) { ThinRes T; T.h = p.h; thin_gemm<ThinRes, 2, 4>(p.P + (size_t)META0 * HID, HID, p.Wt2, HID, 2048, 8, 1, 0, 0, T, smem); }
        }
        xcd_barrier(xb);
    }
    final_phase(p);
}

extern "C" void kernel_launch(void* const* d_in, const int* in_sizes, int n_in, void* d_out, int out_size, void* d_ws, size_t ws_size, hipStream_t stream) {
    static int grid_blocks = 0;
    if (!grid_blocks) {
        int dev = 0, cus = 0, per_cu = 0;
        hipGetDevice(&dev);
        hipDeviceGetAttribute(&cus, hipDeviceAttributeMultiprocessorCount, dev);
        hipFuncSetAttribute((const void*)fwd_megakernel, hipFuncAttributeMaxDynamicSharedMemorySize, LDS_BYTES);
        hipOccupancyMaxActiveBlocksPerMultiprocessor(&per_cu, (const void*)fwd_megakernel, 512, LDS_BYTES);
        if (per_cu < 1) per_cu = 1;
        if (per_cu > 1) per_cu = 1;
        grid_blocks = cus * per_cu;
    }
    Params p{};
    const float* const* in = (const float* const*)d_in;
    p.x = in[0]; p.meta = in[1]; p.w_in = in[2]; p.b_gate = in[3]; p.conv_w = in[4]; p.conv_b = in[5]; p.sink = in[6]; p.mbi = in[7]; p.mbf = in[8]; p.gain = in[9];
    p.w_cp = in[10]; p.w_ap = in[11]; p.w_mp = in[12]; p.w_out = in[13]; p.nmix = in[14]; p.nmlp = in[15]; p.w1 = in[16]; p.w2 = in[17]; p.fnorm = in[18];
    p.out = (float*)d_out;
    unsigned char* ws = (unsigned char*)d_ws; size_t off = 0;
    auto take = [&](size_t bytes) { unsigned char* r = ws + off; off += (bytes + 255) & ~(size_t)255; return r; };
    p.Wt_in = (bf16_t*)take((size_t)2 * NIN * 2048 * 2);
    p.Wt_c = (bf16_t*)take((size_t)2 * 2048 * 2048 * 2); p.Wt_a = (bf16_t*)take((size_t)2 * 2048 * 2048 * 2);
    p.Wt_m = (bf16_t*)take((size_t)2 * 2048 * 2048 * 2); p.Wt_o = (bf16_t*)take((size_t)2 * 2048 * 2048 * 2);
    p.Wt1 = (bf16_t*)take((size_t)2 * 2048 * HID * 2); p.Wt2 = (bf16_t*)take((size_t)2 * 2048 * HID * 2);
    p.h = (float*)take((size_t)TP * 2048 * 4); p.xn = (bf16_t*)take((size_t)TP * 2048 * 2);
    p.P = (bf16_t*)take((size_t)TP * PC * 2); p.G = (bf16_t*)take((size_t)TP * GC * 2); p.gt = (float*)take((size_t)TP * 32 * 4);
    p.yc = (bf16_t*)take((size_t)TP * 2048 * 2); p.ya = (bf16_t*)take((size_t)TP * 2048 * 2); p.ym = (bf16_t*)take((size_t)TP * 2048 * 2);
    p.hm = (float*)take((size_t)2 * TP * 2048 * 4); p.mg = (bf16_t*)take((size_t)TP * 2048 * 2);
    p.ropec = (float*)take(2064 * 8 * 4); p.ropes = (float*)take(2064 * 8 * 4);
    p.bar = (unsigned*)take(XCD_BAR_WORDS * 4);
    if (off > ws_size) { fprintf(stderr, "kernel_launch: workspace too small: need %zu, have %zu\n", off, ws_size); return; }
    if (hipMemsetAsync(p.bar, 0, XCD_BAR_WORDS * 4, stream) != hipSuccess) { fprintf(stderr, "kernel_launch: memset of the barrier words failed\n"); return; }
    void* args[] = {&p};
    hipError_t e = hipLaunchCooperativeKernel((const void*)fwd_megakernel, dim3(grid_blocks), dim3(512), args, LDS_BYTES, stream);
    if (e != hipSuccess) fprintf(stderr, "cooperative launch failed: %s (grid %d)\n", hipGetErrorString(e), grid_blocks);
}
```

```cpp
#include <hip/hip_runtime.h>
#include <hip/hip_cooperative_groups.h>
#include <cstdio>
namespace cg = cooperative_groups;

#define LAS __attribute__((address_space(3)))
#define DI __device__ __forceinline__
typedef unsigned short bf16_t;
typedef short bf16x8 __attribute__((ext_vector_type(8)));
typedef float f32x4 __attribute__((ext_vector_type(4)));
typedef float f32x2 __attribute__((ext_vector_type(2)));
typedef unsigned u32x4 __attribute__((ext_vector_type(4)));
typedef unsigned u32x2 __attribute__((ext_vector_type(2)));
typedef __bf16 bf16x2_t __attribute__((ext_vector_type(2)));
#define MFMA16(a, b, c) __builtin_amdgcn_mfma_f32_16x16x32_bf16((a), (b), (c), 0, 0, 0)

constexpr int DM = 2048, TOK = 8256, TP = 8448, META0 = 8192;
constexpr int INC = 21536, NIN = 21760, PC = 15360, GC = 6144, HID = 8192;
constexpr int oCX = 0, oCB = 2048, oCC = 4096, oAQ = 6144, oAK = 8192, oAV = 8704, oMQ = 9216, oMK = 10240, oMV = 11264, oMO = 13312;
constexpr int LDS_BYTES = 144 * 1024;
constexpr int TILES_PER_LAYER = 5792;

struct Params {
    const float *x, *meta, *w_in, *b_gate, *conv_w, *conv_b, *sink, *mbi, *mbf, *gain, *w_cp, *w_ap, *w_mp, *w_out, *nmix, *nmlp, *w1, *w2, *fnorm;
    float* out;
    bf16_t *Wt_in, *Wt_c, *Wt_a, *Wt_m, *Wt_o, *Wt1, *Wt2;
    float* h; bf16_t* xn; bf16_t* P; bf16_t* G; float* gt; bf16_t *yc, *ya, *ym; float* hm; bf16_t* mg; float* ropec; float* ropes; unsigned* bar;
};

DI unsigned pack2(float lo, float hi) { f32x2 v = {lo, hi}; bf16x2_t b = __builtin_convertvector(v, bf16x2_t); return __builtin_bit_cast(unsigned, b); }
DI bf16_t f2bf(float f) { return (bf16_t)(pack2(f, 0.f) & 0xffffu); }
DI float bf_lo(unsigned u) { return __uint_as_float(u << 16); }
DI float bf_hi(unsigned u) { return __uint_as_float(u & 0xffff0000u); }
DI float bf2f(short s) { return __uint_as_float(((unsigned)(unsigned short)s) << 16); }
DI float wave_sum(float v) {
#pragma unroll
    for (int o = 32; o; o >>= 1) v += __shfl_xor(v, o);
    return v;
}
DI int tid_() { int t = threadIdx.x; asm volatile("" : "+v"(t)); return t; }
DI float sigmoidf_(float x) { return __builtin_amdgcn_rcpf(1.f + __expf(-x)); }


#define XB_TMO      128
#define XB_XCNT(j)  (256  + 64 * (j))
#define XB_XSUB(j)  (1280 + 64 * (j))
#define XB_XGEN(j)  (2304 + 64 * (j))
#define XB_TOP      3328
#define XB_TOPGEN   3392
#define XCD_BAR_WORDS 3456
#define XB_SPIN_CAP (1u << 18)
DI unsigned xb_ld(unsigned* p)              { return __hip_atomic_load(p, __ATOMIC_RELAXED, __HIP_MEMORY_SCOPE_AGENT); }
DI unsigned xb_add(unsigned* p, unsigned v) { return __hip_atomic_fetch_add(p, v, __ATOMIC_RELAXED, __HIP_MEMORY_SCOPE_AGENT); }
DI unsigned xb_xcc_id() { return (unsigned)__builtin_amdgcn_s_getreg((3 << 11) | 20) & 0xFu; }
#define XB_SPIN(cond, bar) do { unsigned _sp = 0; while (cond) { __builtin_amdgcn_s_sleep(1); \
    if ((++_sp & 255u) == 0u) { if (xb_ld(&(bar)[XB_TMO])) break; if (_sp > XB_SPIN_CAP) { atomicAdd(&(bar)[XB_TMO], 1u); break; } } } } while (0)
struct XcdBarrier { unsigned* bar; unsigned x; volatile LAS unsigned* st; };
DI XcdBarrier xcd_barrier_post(unsigned* bar, volatile LAS unsigned* st) {
    XcdBarrier b; b.bar = bar; b.x = xb_xcc_id(); b.st = st;
    if (threadIdx.x == 0) (void)xb_add(&bar[XB_XCNT(b.x)], 1u);
    return b;
}
DI void xcd_barrier_complete(unsigned* bar, unsigned x, unsigned& nloc, unsigned& nx) {
    const unsigned G = gridDim.x * gridDim.y * gridDim.z;
    unsigned sum, cnt, mine, sp = 0u;
    for (;;) {
        sum = 0u; cnt = 0u; mine = 0u;
#pragma unroll
        for (unsigned j = 0; j < 16; ++j) { const unsigned c = xb_ld(&bar[XB_XCNT(j)]); sum += c; cnt += (c > 0u) ? 1u : 0u; mine = (j == x) ? c : mine; }
        if (sum == G) break;
        __builtin_amdgcn_s_sleep(1);
        if ((++sp & 255u) == 0u) { if (xb_ld(&bar[XB_TMO])) break; if (sp > XB_SPIN_CAP) { atomicAdd(&bar[XB_TMO], 1u); break; } }
    }
    nloc = mine > 0u ? mine : 1u; nx = cnt > 0u ? cnt : 1u;
}
DI void xcd_barrier(const XcdBarrier& b) {
    asm volatile("s_waitcnt vmcnt(0)" ::: "memory");
    __syncthreads();
    if (threadIdx.x == 0) {
        unsigned* bar = b.bar;
        __builtin_amdgcn_s_waitcnt(0);
        unsigned nloc = b.st[0], nx = b.st[1];
        if (nloc == 0u) { xcd_barrier_complete(bar, b.x, nloc, nx); b.st[0] = nloc; b.st[1] = nx; }
        const unsigned old = xb_add(&bar[XB_XSUB(b.x)], 1u);
        const unsigned gen = old / nloc;
        if (old + 1u == (gen + 1u) * nloc) {
            __builtin_amdgcn_fence(__ATOMIC_RELEASE, "agent");
            asm volatile("s_waitcnt vmcnt(0)" ::: "memory");
            const unsigned og = xb_add(&bar[XB_TOP], 1u);
            const unsigned tg = og / nx;
            if (og + 1u == (tg + 1u) * nx) xb_add(&bar[XB_TOPGEN], 1u);
            else XB_SPIN(xb_ld(&bar[XB_TOPGEN]) == tg, bar);
            __builtin_amdgcn_fence(__ATOMIC_ACQUIRE, "agent");
            xb_add(&bar[XB_XGEN(b.x)], 1u);
            asm volatile("s_waitcnt vmcnt(0)" ::: "memory");
        } else {
            XB_SPIN(xb_ld(&bar[XB_XGEN(b.x)]) == gen, bar);
            __builtin_amdgcn_fence(__ATOMIC_ACQUIRE, "agent");
            asm volatile("s_waitcnt vmcnt(0)" ::: "memory");
        }
    }
    __syncthreads();
}

namespace pg8 {
constexpr int BM = 256, BK = 64, HALF = 128, HTB = HALF * BK * 2, STAGE_BYTES = 8 * HTB, NXCD = 8, WGM = 4;
DI int lds_byte(int r, int c) { const int st = (r >> 4) * 2 + (c >> 5), rr = r & 15, cc = c & 31, ob = rr * 64 + cc * 2; return st * 1024 + (ob ^ (((ob >> 9) & 1) << 5)); }
DI void stage_rc(int b, int& R, int& C) { const int st = b / 1024, sb = b % 1024, swz = sb ^ (((sb >> 9) & 1) << 5); R = (st >> 1) * 16 + swz / 64; C = (st & 1) * 32 + (swz % 64) / 2; }
DI int perm32(int rho) { const int n = rho >> 4, i = rho & 15; return 8 * (i >> 2) + 4 * n + (i & 3); }
struct Unit { int pm, pn, z; };

struct Sched {
    int nM, nN, nwg, G, c, nz;
    const char *A0, *B0;
    size_t tstep, zA, zB;
    DI void init(int M, int N, int K, int G_, int c_, int nz_) { nM = M / BM; nN = N / BM; nwg = nM * nN; G = G_; c = c_; nz = nz_; tstep = (size_t)BM * K * 2; zA = zB = 0; }
    DI bool next(int i, Unit& u) const {
        const int z = i % nz, ii = i / nz;
        const long L = (long)ii * G + c; if (L >= nwg) return false;
        int wgid = (int)L; { const int q = nwg / NXCD, r = nwg % NXCD, xcd = wgid % NXCD, off = wgid / NXCD; wgid = (xcd < r ? xcd * (q + 1) : r * (q + 1) + (xcd - r) * q) + off; }
        const int nig = WGM * nN, gid = wgid / nig, fm = gid * WGM, gsz = (nM - fm) < WGM ? (nM - fm) : WGM;
        u.pm = fm + ((wgid % nig) % gsz); u.pn = (wgid % nig) / gsz; u.z = z; return true;
    }
    DI const char* aBase(const Unit& u) const { return A0 + (size_t)u.z * zA + (size_t)u.pm * tstep; }
    DI const char* bBase(const Unit& u) const { return B0 + (size_t)u.z * zB + (size_t)u.pn * tstep; }
};

template <class Epi>
DI void gemm_phase(LAS unsigned char* lds, const int K, const Sched& S, const Epi& E) {
    const int tid = tid_(), wid = __builtin_amdgcn_readfirstlane(tid >> 6), lane = tid & 63, wr = wid >> 2, wc = wid & 3, fr = lane & 15, fq = lane >> 4;
    const int nt = K / BK;
    unsigned voffA[2], voffB[2];
#pragma unroll
    for (int i = 0; i < 2; ++i) { int R, C; stage_rc(tid * 16 + i * 8192, R, C); const int Rb = Epi::PERM ? ((R & ~31) + perm32(R & 31)) : R;
        voffA[i] = (unsigned)(R * K + C) * 2u; voffB[i] = (unsigned)(Rb * K + C) * 2u; }
    const size_t kstep = (size_t)(BK * 2);
    const size_t hstep = (size_t)HALF * K * 2;
    const unsigned ldsw = (unsigned)wid * 1024u;
    const int aoff = lds_byte(wr * 64 + fr, fq * 8), boff = lds_byte(wc * 32 + fr, fq * 8);
#define PG8_SA(b, h) (((b) * 2 + (h)) * HTB)
#define PG8_SB(b, h) ((4 + (b) * 2 + (h)) * HTB)
#define PG8_STAGE(bufoff, gbase, voff) do { _Pragma("unroll") for (int _i = 0; _i < 2; ++_i) \
        __builtin_amdgcn_global_load_lds((const unsigned*)((const char*)(gbase) + (voff)[_i]), (LAS unsigned*)(lds + (bufoff) + ldsw + _i * 8192), 16, 0, 0); } while (0)
#define PG8_LDA(dst, b, h) do { _Pragma("unroll") for (int m = 0; m < 4; ++m) _Pragma("unroll") for (int k = 0; k < 2; ++k) dst[m][k] = *(const LAS bf16x8*)(lds + PG8_SA(b, h) + aoff + m * 2048 + k * 1024); } while (0)
#define PG8_LDB(dst, b, h) do { _Pragma("unroll") for (int n = 0; n < 2; ++n) _Pragma("unroll") for (int k = 0; k < 2; ++k) dst[n][k] = *(const LAS bf16x8*)(lds + PG8_SB(b, h) + boff + n * 2048 + k * 1024); } while (0)
#define PG8_MMA(ai, bj, At, Bt) do { __builtin_amdgcn_s_setprio(1); _Pragma("unroll") for (int m = 0; m < 4; ++m) _Pragma("unroll") for (int n = 0; n < 2; ++n) _Pragma("unroll") for (int k = 0; k < 2; ++k) \
        acc[ai][bj][m][n] = __builtin_amdgcn_mfma_f32_16x16x32_bf16(Bt[n][k], At[m][k], acc[ai][bj][m][n], 0, 0, 0); __builtin_amdgcn_s_setprio(0); } while (0)
#define PG8_WAIT_V(n) asm volatile("s_waitcnt vmcnt(" #n ")" ::: "memory")
#define PG8_WAIT_L(n) asm volatile("s_waitcnt lgkmcnt(" #n ")" ::: "memory")
#define PG8_BAR __builtin_amdgcn_s_barrier()
#define PG8_SCHED __builtin_amdgcn_sched_barrier(0)
    Unit cur, nxt; int ui = 0;
    if (!S.next(0, cur)) return;
    f32x4 acc[2][2][4][2];
#pragma unroll
    for (int a = 0; a < 2; ++a)
#pragma unroll
        for (int b = 0; b < 2; ++b)
#pragma unroll
            for (int m = 0; m < 4; ++m)
#pragma unroll
                for (int n = 0; n < 2; ++n) acc[a][b][m][n] = (f32x4){0.f, 0.f, 0.f, 0.f};
    bf16x8 At[4][2], B0[2][2], B1[2][2];
    const char* cA = S.aBase(cur); const char* cB = S.bBase(cur);
    PG8_STAGE(PG8_SB(0, 0), cB, voffB); PG8_STAGE(PG8_SA(0, 0), cA, voffA); PG8_STAGE(PG8_SB(0, 1), cB + hstep, voffB); PG8_STAGE(PG8_SA(0, 1), cA + hstep, voffA);
    if (wr == 1) PG8_BAR;
    PG8_WAIT_V(4); PG8_BAR;
    PG8_STAGE(PG8_SB(1, 0), cB + kstep, voffB); PG8_STAGE(PG8_SA(1, 0), cA + kstep, voffA); PG8_STAGE(PG8_SB(1, 1), cB + hstep + kstep, voffB);
    PG8_WAIT_V(6); PG8_BAR;
    for (;;) {
        const bool has_next = S.next(ui + 1, nxt);
        const char* nA = has_next ? S.aBase(nxt) : cA; const char* nB = has_next ? S.bBase(nxt) : cB;
        for (int t = 0; t < nt; t += 2) {
            const bool last = (t == nt - 2);
            const char* a1 = cA + (size_t)(t + 1) * kstep;
            const char* a2 = last ? nA : cA + (size_t)(t + 2) * kstep; const char* b2 = last ? nB : cB + (size_t)(t + 2) * kstep;
            const char* a3 = a2 + kstep; const char* b3 = b2 + kstep;
            PG8_LDB(B0, 0, 0); PG8_SCHED; PG8_LDA(At, 0, 0); PG8_STAGE(PG8_SA(1, 1), a1 + hstep, voffA);
            PG8_WAIT_L(8); PG8_BAR; PG8_WAIT_L(0); PG8_MMA(0, 0, At, B0); PG8_BAR; PG8_SCHED;
            PG8_LDB(B1, 0, 1); PG8_STAGE(PG8_SB(0, 0), b2, voffB);
            PG8_BAR; PG8_WAIT_L(0); PG8_MMA(0, 1, At, B1); PG8_BAR;
            PG8_LDA(At, 0, 1); PG8_STAGE(PG8_SA(0, 0), a2, voffA);
            PG8_BAR; PG8_WAIT_L(0); PG8_MMA(1, 0, At, B0); PG8_BAR; PG8_SCHED;
            PG8_STAGE(PG8_SB(0, 1), b2 + hstep, voffB);
            PG8_WAIT_V(6); PG8_BAR; PG8_MMA(1, 1, At, B1); PG8_BAR;
            PG8_LDB(B0, 1, 0); PG8_SCHED; PG8_LDA(At, 1, 0); PG8_STAGE(PG8_SA(0, 1), a2 + hstep, voffA);
            PG8_WAIT_L(8); PG8_BAR; PG8_WAIT_L(0); PG8_MMA(0, 0, At, B0); PG8_BAR; PG8_SCHED;
            PG8_LDB(B1, 1, 1); PG8_STAGE(PG8_SB(1, 0), b3, voffB);
            PG8_BAR; PG8_WAIT_L(0); PG8_MMA(0, 1, At, B1); PG8_BAR;
            PG8_LDA(At, 1, 1); PG8_STAGE(PG8_SA(1, 0), a3, voffA);
            PG8_BAR; PG8_WAIT_L(0); PG8_MMA(1, 0, At, B0); PG8_BAR; PG8_SCHED;
            PG8_STAGE(PG8_SB(1, 1), b3 + hstep, voffB);
            PG8_WAIT_V(6); PG8_BAR; PG8_MMA(1, 1, At, B1); PG8_BAR;
        }
        bool keep = false;
        if constexpr (Epi::CARRY) keep = E.carry(acc, cur, wr, wc, fr, fq); else E(acc, cur, wr, wc, fr, fq);
        if (!has_next) break;
        if (!keep) {
#pragma unroll
        for (int a = 0; a < 2; ++a)
#pragma unroll
            for (int b = 0; b < 2; ++b)
#pragma unroll
                for (int m = 0; m < 4; ++m)
#pragma unroll
                    for (int n = 0; n < 2; ++n) acc[a][b][m][n] = (f32x4){0.f, 0.f, 0.f, 0.f};
        }
        cur = nxt; cA = nA; cB = nB; ++ui;
    }
    PG8_WAIT_V(0);
    if (wr == 0) PG8_BAR;
    PG8_BAR;
#undef PG8_SA
#undef PG8_SB
#undef PG8_STAGE
#undef PG8_LDA
#undef PG8_LDB
#undef PG8_MMA
#undef PG8_WAIT_V
#undef PG8_WAIT_L
#undef PG8_BAR
#undef PG8_SCHED
}
}
using pg8::Unit;

struct EpiIn {
    static constexpr bool PERM = true, CARRY = false;
    bf16_t* P; bf16_t* G; float* gt; const float* bgate;
    DI void operator()(const f32x4 (&acc)[2][2][4][2], const Unit& u, int wr, int wc, int fr, int fq) const {
        asm volatile("" : "+v"(fr), "+v"(fq));
        const int row0 = u.pm * 256 + wr * 64 + fr;
        if (u.pn < 16) {
            const int col0 = oCX + u.pn * 128 + wc * 32 + 8 * fq;
#pragma unroll
            for (int ai = 0; ai < 2; ++ai)
#pragma unroll
                for (int m = 0; m < 4; ++m) { const f32x4 v0 = acc[ai][0][m][0] * acc[ai][1][m][0], v1 = acc[ai][0][m][1] * acc[ai][1][m][1];
                    u32x4 w; w.x = pack2(v0[0], v0[1]); w.y = pack2(v0[2], v0[3]); w.z = pack2(v1[0], v1[1]); w.w = pack2(v1[2], v1[3]);
                    *(u32x4*)(P + (size_t)(row0 + ai * 128 + m * 16) * PC + col0) = w; }
        } else if (u.pn < 60) {
            const int col0 = (u.pn < 24 ? (u.pn - 8) * 256 : u.pn * 256) + wc * 32 + 8 * fq;
#pragma unroll
            for (int ai = 0; ai < 2; ++ai)
#pragma unroll
                for (int m = 0; m < 4; ++m) { bf16_t* rowp = P + (size_t)(row0 + ai * 128 + m * 16) * PC + col0;
#pragma unroll
                    for (int bj = 0; bj < 2; ++bj) { const f32x4 v0 = acc[ai][bj][m][0], v1 = acc[ai][bj][m][1];
                        u32x4 w; w.x = pack2(v0[0], v0[1]); w.y = pack2(v0[2], v0[3]); w.z = pack2(v1[0], v1[1]); w.w = pack2(v1[2], v1[3]);
                        *(u32x4*)(rowp + bj * 128) = w; } }
        } else if (u.pn < 84) {
            const int col0 = (u.pn - 60) * 256 + wc * 32 + 8 * fq;
            f32x4 bv[2][2];
#pragma unroll
            for (int bj = 0; bj < 2; ++bj)
#pragma unroll
                for (int n = 0; n < 2; ++n) bv[bj][n] = *(const f32x4*)(bgate + col0 + bj * 128 + 4 * n);
#pragma unroll
            for (int ai = 0; ai < 2; ++ai)
#pragma unroll
                for (int m = 0; m < 4; ++m) { bf16_t* rowp = G + (size_t)(row0 + ai * 128 + m * 16) * GC + col0;
#pragma unroll
                    for (int bj = 0; bj < 2; ++bj) { const f32x4 v0 = acc[ai][bj][m][0] + bv[bj][0], v1 = acc[ai][bj][m][1] + bv[bj][1];
                        u32x4 w; w.x = pack2(sigmoidf_(v0[0]), sigmoidf_(v0[1])); w.y = pack2(sigmoidf_(v0[2]), sigmoidf_(v0[3]));
                        w.z = pack2(sigmoidf_(v1[0]), sigmoidf_(v1[1])); w.w = pack2(sigmoidf_(v1[2]), sigmoidf_(v1[3]));
                        *(u32x4*)(rowp + bj * 128) = w; } }
        } else {
            if (wc == 0) {
#pragma unroll
                for (int ai = 0; ai < 2; ++ai)
#pragma unroll
                    for (int m = 0; m < 4; ++m) { float* rowp = gt + (size_t)(row0 + ai * 128 + m * 16) * 32 + 8 * fq;
                        *(f32x4*)rowp = acc[ai][0][m][0]; *(f32x4*)(rowp + 4) = acc[ai][0][m][1]; }
            }
        }
    }
};
struct EpiBr {
    static constexpr bool PERM = false, CARRY = true;
    const bf16_t* G; bf16_t* mg;
    DI bool carry(f32x4 (&acc)[2][2][4][2], const Unit& u, int wr, int wc, int fr, int fq) const {
        asm volatile("" : "+v"(fr), "+v"(fq));
        const int row0 = u.pm * 256 + wr * 64 + fr, col0 = u.pn * 256 + wc * 32 + 4 * fq;
#pragma unroll
        for (int ai = 0; ai < 2; ++ai)
#pragma unroll
            for (int m = 0; m < 4; ++m) { const size_t row = (size_t)(row0 + ai * 128 + m * 16);
#pragma unroll
                for (int bj = 0; bj < 2; ++bj)
#pragma unroll
                    for (int n = 0; n < 2; ++n) { const int col = col0 + bj * 128 + n * 16;
                        const u32x2 g = *(const u32x2*)(G + row * GC + u.z * 2048 + col);
                        f32x4 f = {bf_lo(g.x), bf_hi(g.x), bf_lo(g.y), bf_hi(g.y)};
                        if (u.z < 2) { const u32x2 gn = *(const u32x2*)(G + row * GC + (u.z + 1) * 2048 + col);
                            f[0] *= __builtin_amdgcn_rcpf(fmaxf(bf_lo(gn.x), 1e-30f)); f[1] *= __builtin_amdgcn_rcpf(fmaxf(bf_hi(gn.x), 1e-30f));
                            f[2] *= __builtin_amdgcn_rcpf(fmaxf(bf_lo(gn.y), 1e-30f)); f[3] *= __builtin_amdgcn_rcpf(fmaxf(bf_hi(gn.y), 1e-30f));
                            acc[ai][bj][m][n] *= f; }
                        else { const f32x4 v = acc[ai][bj][m][n] * f; u32x2 w; w.x = pack2(v[0], v[1]); w.y = pack2(v[2], v[3]); *(u32x2*)(mg + row * 2048 + col) = w; } } }
        return u.z < 2;
    }
};
struct EpiRes {
    static constexpr bool PERM = false, CARRY = false;
    float* h;
    DI void operator()(const f32x4 (&acc)[2][2][4][2], const Unit& u, int wr, int wc, int fr, int fq) const {
        asm volatile("" : "+v"(fr), "+v"(fq));
        const int row0 = u.pm * 256 + wr * 64 + fr, col0 = u.pn * 256 + wc * 32 + 4 * fq;
#pragma unroll
        for (int ai = 0; ai < 2; ++ai)
#pragma unroll
            for (int m = 0; m < 4; ++m) { float* rowp = h + (size_t)(row0 + ai * 128 + m * 16) * 2048 + col0;
#pragma unroll
                for (int bj = 0; bj < 2; ++bj)
#pragma unroll
                    for (int n = 0; n < 2; ++n) { float* q = rowp + bj * 128 + n * 16; *(f32x4*)q = *(const f32x4*)q + acc[ai][bj][m][n]; } }
    }
};
struct EpiUp {
    static constexpr bool PERM = true, CARRY = false;
    bf16_t* act;
    DI void operator()(const f32x4 (&acc)[2][2][4][2], const Unit& u, int wr, int wc, int fr, int fq) const {
        asm volatile("" : "+v"(fr), "+v"(fq));
        const int row0 = u.pm * 256 + wr * 64 + fr, col0 = u.pn * 256 + wc * 32 + 8 * fq;
#pragma unroll
        for (int ai = 0; ai < 2; ++ai)
#pragma unroll
            for (int m = 0; m < 4; ++m) { bf16_t* rowp = act + (size_t)(row0 + ai * 128 + m * 16) * HID + col0;
#pragma unroll
                for (int bj = 0; bj < 2; ++bj) { f32x4 v0 = acc[ai][bj][m][0], v1 = acc[ai][bj][m][1];
#pragma unroll
                    for (int j = 0; j < 4; ++j) { const float a = fmaxf(v0[j], 0.f), b = fmaxf(v1[j], 0.f); v0[j] = a * a; v1[j] = b * b; }
                    u32x4 w; w.x = pack2(v0[0], v0[1]); w.y = pack2(v0[2], v0[3]); w.z = pack2(v1[0], v1[1]); w.w = pack2(v1[2], v1[3]);
                    *(u32x4*)(rowp + bj * 128) = w; } }
    }
};


struct ThinBr {
    const bf16_t* G; bf16_t* mg;
    DI void gate(int z, int m, int n, int cg, int fr, int fq, const f32x4& a, f32x4& t) const {
        const u32x2 g = *(const u32x2*)(G + (size_t)(META0 + m * 16 + fr) * GC + z * 2048 + cg * 64 + n * 16 + 4 * fq);
        t[0] += a[0] * bf_lo(g.x); t[1] += a[1] * bf_hi(g.x); t[2] += a[2] * bf_lo(g.y); t[3] += a[3] * bf_hi(g.y);
    }
    DI void store(int row, int col, const f32x4& v) const { u32x2 w; w.x = pack2(v[0], v[1]); w.y = pack2(v[2], v[3]); *(u32x2*)(mg + (size_t)(META0 + row) * 2048 + col) = w; }
};
struct ThinRes {
    float* h;
    DI void gate(int, int, int, int, int, int, const f32x4& a, f32x4& t) const { t += a; }
    DI void store(int row, int col, const f32x4& v) const { float* q = h + (size_t)(META0 + row) * 2048 + col;
#pragma unroll
        for (int j = 0; j < 4; ++j) (void)__hip_atomic_fetch_add(q + j, v[j], __ATOMIC_RELAXED, __HIP_MEMORY_SCOPE_AGENT); }
};
struct ThinUp {
    bf16_t* act;
    DI void gate(int, int, int, int, int, int, const f32x4& a, f32x4& t) const { t += a; }
    DI void store(int row, int col, const f32x4& v) const { const float a = fmaxf(v[0], 0.f), b = fmaxf(v[1], 0.f), c = fmaxf(v[2], 0.f), d = fmaxf(v[3], 0.f);
        u32x2 w; w.x = pack2(a * a, b * b); w.y = pack2(c * c, d * d); *(u32x2*)(act + (size_t)(META0 + row) * HID + col) = w; }
};
template <class TE, int UNR, int MT>
DI void thin_gemm(const bf16_t* A, int lda, const bf16_t* Bt, int K, int N, int ksplit, int nz, size_t zA, size_t zB, const TE& E, unsigned char* smem) {
    const int tid = tid_(), lane = tid & 63, w = tid >> 6, fr = lane & 15, fq = lane >> 4;
    const int ncg = N >> 6, nck = ncg * ksplit, nitems = nck * (4 / MT), kw = K / (ksplit * 8);
    float* red = (float*)smem;
    for (int item = blockIdx.x; item < nitems; item += gridDim.x) {
        const int cg = item % ncg, kg = (item / ncg) % ksplit, mh = (item / nck) * MT;
        const int k0 = kg * (K / ksplit) + w * kw;
        f32x4 tot[MT][4];
#pragma unroll
        for (int m = 0; m < MT; ++m)
#pragma unroll
            for (int n = 0; n < 4; ++n) tot[m][n] = (f32x4){0.f, 0.f, 0.f, 0.f};
#pragma unroll 1
        for (int z = 0; z < nz; ++z) {
            f32x4 acc[MT][4];
#pragma unroll
            for (int m = 0; m < MT; ++m)
#pragma unroll
                for (int n = 0; n < 4; ++n) acc[m][n] = (f32x4){0.f, 0.f, 0.f, 0.f};
            const bf16_t* Az = A + (size_t)z * zA + (size_t)(mh * 16 + fr) * lda + k0 + 8 * fq;
            const bf16_t* Bz = Bt + (size_t)z * zB + (size_t)(cg * 64 + fr) * K + k0 + 8 * fq;
#pragma unroll UNR
            for (int ks = 0; ks < kw; ks += 32) {
                bf16x8 af[MT], bfr[4];
#pragma unroll
                for (int m = 0; m < MT; ++m) af[m] = *(const bf16x8*)(Az + (size_t)(m * 16) * lda + ks);
#pragma unroll
                for (int n = 0; n < 4; ++n) bfr[n] = *(const bf16x8*)(Bz + (size_t)(n * 16) * K + ks);
#pragma unroll
                for (int m = 0; m < MT; ++m)
#pragma unroll
                    for (int n = 0; n < 4; ++n) acc[m][n] = MFMA16(bfr[n], af[m], acc[m][n]);
            }
#pragma unroll
            for (int m = 0; m < MT; ++m)
#pragma unroll
                for (int n = 0; n < 4; ++n) E.gate(z, mh + m, n, cg, fr, fq, acc[m][n], tot[m][n]);
        }
        __syncthreads();
#pragma unroll
        for (int m = 0; m < MT; ++m)
#pragma unroll
            for (int n = 0; n < 4; ++n) *(f32x4*)(red + ((w * 64 + m * 16 + fr) * 64 + n * 16 + 4 * fq)) = tot[m][n];
        __syncthreads();
#pragma unroll
        for (int i = 0; i < (MT + 1) / 2; ++i) { const int slot = tid + 512 * i; const int row = slot >> 4, c4 = (slot & 15) * 4;
            if (row < MT * 16) {
                f32x4 sres = {0.f, 0.f, 0.f, 0.f};
#pragma unroll
                for (int ww = 0; ww < 8; ++ww) sres += *(const f32x4*)(red + ((ww * 64 + row) * 64 + c4));
                E.store(mh * 16 + row, cg * 64 + c4, sres); } }
    }
    __syncthreads();
}

struct ConvJob { const float* src; bf16_t* dst; int pitch, col0, ncols, K, tile, split; };
DI void conv_load(const ConvJob& j, f32x4 (&v)[8], int tid) {
    const int nkt = j.K >> 6; const int kt = j.tile % nkt, nt = j.tile / nkt; const int k0 = kt * 64, n0 = nt * 256;
    const int nc = (tid & 63) * 4, kr = tid >> 6;
#pragma unroll
    for (int i = 0; i < 8; ++i) { const int k = k0 + kr + 8 * i;
        const int scol = j.split ? (nc < 128 ? 128 * nt + nc : 4096 + 128 * nt + nc - 128) : j.col0 + n0 + nc;
        v[i] = (n0 + nc < j.ncols) ? __builtin_nontemporal_load((const f32x4*)(j.src + (size_t)k * j.pitch + scol)) : (f32x4){0.f, 0.f, 0.f, 0.f}; }
}
DI void conv_store(const ConvJob& j, const f32x4 (&v)[8], float* tl, int tid) {
    const int nkt = j.K >> 6; const int kt = j.tile % nkt, nt = j.tile / nkt; const int k0 = kt * 64, n0 = nt * 256;
    const int nc = (tid & 63) * 4, kr = tid >> 6;
    __syncthreads();
#pragma unroll
    for (int i = 0; i < 8; ++i) *(f32x4*)(tl + (kr + 8 * i) * 260 + ((nc + 8 * i) & 255)) = v[i];
    __syncthreads();
#pragma unroll
    for (int i = 0; i < 4; ++i) { const int idx = tid + 512 * i; const int n = idx >> 3, kc = (idx & 7) * 8;
        float e[8];
#pragma unroll
        for (int jj = 0; jj < 8; ++jj) e[jj] = tl[(kc + jj) * 260 + ((n + kc) & 255)];
        u32x4 w; w.x = pack2(e[0], e[1]); w.y = pack2(e[2], e[3]); w.z = pack2(e[4], e[5]); w.w = pack2(e[6], e[7]);
        *(u32x4*)(j.dst + (size_t)(n0 + n) * j.K + k0 + kc) = w; }
}
DI ConvJob conv_job(const Params& p, int t) {
    const int l = t / TILES_PER_LAYER; const int u = t % TILES_PER_LAYER;
    const float* win = p.w_in + (size_t)l * 2048 * INC; bf16_t* wtin = p.Wt_in + (size_t)l * NIN * 2048;
    const size_t sq = (size_t)l * 2048 * 2048;
    ConvJob j; j.col0 = 0; j.K = 2048; j.split = 0;
    if (u < 512) { j.src = win; j.pitch = INC; j.ncols = 4096; j.dst = wtin; j.tile = u; j.split = 1; }
    else if (u < 768) { j.src = win; j.pitch = INC; j.col0 = 2048; j.ncols = 2048; j.dst = wtin + (size_t)4096 * 2048; j.tile = u - 512; }
    else if (u < 1920) { j.src = win; j.pitch = INC; j.col0 = 6144; j.ncols = 9216; j.dst = wtin + (size_t)6144 * 2048; j.tile = u - 768; }
    else if (u < 2688) { j.src = win; j.pitch = INC; j.col0 = 15392; j.ncols = 6144; j.dst = wtin + (size_t)15360 * 2048; j.tile = u - 1920; }
    else if (u < 2720) { j.src = win; j.pitch = INC; j.col0 = 15360; j.ncols = 32; j.dst = wtin + (size_t)21504 * 2048; j.tile = u - 2688; }
    else if (u < 2976) { j.src = p.w_cp + sq; j.pitch = 2048; j.ncols = 2048; j.dst = p.Wt_c + sq; j.tile = u - 2720; }
    else if (u < 3232) { j.src = p.w_ap + sq; j.pitch = 2048; j.ncols = 2048; j.dst = p.Wt_a + sq; j.tile = u - 2976; }
    else if (u < 3488) { j.src = p.w_mp + sq; j.pitch = 2048; j.ncols = 2048; j.dst = p.Wt_m + sq; j.tile = u - 3232; }
    else if (u < 3744) { j.src = p.w_out + sq; j.pitch = 2048; j.ncols = 2048; j.dst = p.Wt_o + sq; j.tile = u - 3488; }
    else if (u < 4768) { j.src = p.w1 + (size_t)l * 2048 * HID; j.pitch = HID; j.ncols = HID; j.dst = p.Wt1 + (size_t)l * 2048 * HID; j.tile = u - 3744; }
    else { j.src = p.w2 + (size_t)l * 2048 * HID; j.pitch = 2048; j.ncols = 2048; j.K = HID; j.dst = p.Wt2 + (size_t)l * 2048 * HID; j.tile = u - 4768; }
    return j;
}

DI void norm_row(const float* src, const float* g, bf16_t* xn_row, float* h_row, int lane) {
    f32x4 v[8]; float ss = 0.f;
#pragma unroll
    for (int i = 0; i < 8; ++i) { v[i] = *(const f32x4*)(src + (i * 64 + lane) * 4); ss += v[i][0] * v[i][0] + v[i][1] * v[i][1] + v[i][2] * v[i][2] + v[i][3] * v[i][3]; }
    ss = wave_sum(ss);
    const float r = rsqrtf(ss * (1.f / 2048.f) + 1e-6f);
#pragma unroll
    for (int i = 0; i < 8; ++i) { const f32x4 gg = *(const f32x4*)(g + (i * 64 + lane) * 4);
        u32x2 w; w.x = pack2(v[i][0] * r * gg[0], v[i][1] * r * gg[1]); w.y = pack2(v[i][2] * r * gg[2], v[i][3] * r * gg[3]);
        *(u32x2*)(xn_row + (i * 64 + lane) * 4) = w;
        if (h_row) *(f32x4*)(h_row + (i * 64 + lane) * 4) = v[i]; }
}

DI void phase0(const Params& p, unsigned char* smem) {
    const int G = gridDim.x, c = blockIdx.x, tid = threadIdx.x;
    float* tl = (float*)smem;
    {
        int t = (G % 8 == 0) ? (c % 8) * (G / 8) + c / 8 : c;
        ConvJob cur = conv_job(p, t < 2 * TILES_PER_LAYER ? t : 0);
        f32x4 va[8], vb[8];
        if (t < 2 * TILES_PER_LAYER) conv_load(cur, va, tid);
        while (t < 2 * TILES_PER_LAYER) {
            const int tn = t + G; const bool hn = tn < 2 * TILES_PER_LAYER;
            const ConvJob nxt = conv_job(p, hn ? tn : t);
            if (hn) conv_load(nxt, vb, tid);
            conv_store(cur, va, tl, tid);
#pragma unroll
            for (int i = 0; i < 8; ++i) va[i] = vb[i];
            cur = nxt; t = tn;
        }
    }
    const int gtid = c * 512 + tid, gstride = G * 512;
    for (int i = gtid; i < 2064 * 8; i += gstride) {
        const int pos = i >> 3, f = i & 7;
        const float invf = f == 0 ? 1.0f : f == 1 ? 0.1939227432012558f : f == 2 ? 0.03760603070259094f : f == 3 ? 0.007292664609849453f : f == 4 ? 0.0014142135623842478f
                         : f == 5 ? 0.00027424818836152554f : f == 6 ? 5.318296098266728e-05f : 1.0313386155758053e-05f;
        const float ang = (float)pos * invf;
        double a = (double)ang; const double k = rint(a * 0.15915494309189535); a -= k * 6.283185307179586;
        const double a2 = a * a;
        double ts = 1.0, tc = 1.0, sn = 1.0, cs = 1.0;
#pragma unroll 1
        for (int n = 1; n <= 14; ++n) { tc *= -a2 / (double)((2 * n - 1) * (2 * n)); ts *= -a2 / (double)((2 * n) * (2 * n + 1)); cs += tc; sn += ts; }
        sn *= a;
        p.ropec[i] = (float)cs; p.ropes[i] = (float)sn;
    }
    for (int i = gtid; i < (TP - TOK) * 2048 / 8; i += gstride) { const size_t o = (size_t)TOK * 2048 + (size_t)i * 8; const u32x4 z = {0u, 0u, 0u, 0u};
        *(u32x4*)(p.xn + o) = z; *(u32x4*)(p.yc + o) = z; *(u32x4*)(p.ya + o) = z; *(u32x4*)(p.ym + o) = z;
        *(f32x4*)(p.h + o) = (f32x4){0.f, 0.f, 0.f, 0.f}; *(f32x4*)(p.h + o + 4) = (f32x4){0.f, 0.f, 0.f, 0.f}; }
    const int lane = tid & 63, gw = (c * 512 + tid) >> 6, nw = G * 8;
    for (int r = gw; r < TOK; r += nw) {
        const float* src = r < META0 ? p.x + (size_t)r * 2048 : p.meta + (size_t)((r - META0) & 15) * 2048;
        norm_row(src, p.nmix, p.xn + (size_t)r * 2048, p.h + (size_t)r * 2048, lane);
    }
}

template <int R, bool OUT_F32>
DI void norm_rows(const Params& p, const float* g, int nrows) {
    const int tid = tid_(); const int lane = tid & 63, gw = (blockIdx.x * 512 + tid) >> 6, nw = gridDim.x * 8;
    for (int r0 = gw; r0 < nrows; r0 += R * nw) {
        f32x4 v[R][8]; float ss[R];
#pragma unroll
        for (int k = 0; k < R; ++k) { const int r = r0 + k * nw; const float* src = p.h + (size_t)(r < nrows ? r : r0) * 2048;
#pragma unroll
            for (int i = 0; i < 8; ++i) v[k][i] = *(const f32x4*)(src + (i * 64 + lane) * 4); }
#pragma unroll
        for (int k = 0; k < R; ++k) { float a = 0.f;
#pragma unroll
            for (int i = 0; i < 8; ++i) a += v[k][i][0] * v[k][i][0] + v[k][i][1] * v[k][i][1] + v[k][i][2] * v[k][i][2] + v[k][i][3] * v[k][i][3];
            ss[k] = rsqrtf(wave_sum(a) * (1.f / 2048.f) + 1e-6f); }
#pragma unroll
        for (int i = 0; i < 8; ++i) { const f32x4 gg = *(const f32x4*)(g + (i * 64 + lane) * 4);
#pragma unroll
            for (int k = 0; k < R; ++k) { const int r = r0 + k * nw;
                if (r < nrows) { const f32x4 y = v[k][i] * ss[k] * gg;
                    if (OUT_F32) *(f32x4*)(p.out + (size_t)r * 2048 + (i * 64 + lane) * 4) = y;
                    else { u32x2 w; w.x = pack2(y[0], y[1]); w.y = pack2(y[2], y[3]); *(u32x2*)(p.xn + (size_t)r * 2048 + (i * 64 + lane) * 4) = w; } } } }
    }
}
DI void norm_phase(const Params& p, const float* g) { norm_rows<2, false>(p, g, TOK); }
DI void final_phase(const Params& p) { norm_rows<2, true>(p, p.fnorm, META0); }

typedef short s16x4 __attribute__((ext_vector_type(4)));
DI u32x2 trread(const bf16_t* T, int pitch, int row0, int col0, int lane) {
    const int q = (lane & 15) >> 2, pp = lane & 3;
    const s16x4 v = __builtin_amdgcn_ds_read_tr16_b64_v4i16((LAS s16x4*)(T + (row0 + q) * pitch + col0 + 4 * pp));
    return __builtin_bit_cast(u32x2, v);
}
DI bf16x8 join8(u32x2 lo, u32x2 hi) { u32x4 w; w.x = lo.x; w.y = lo.y; w.z = hi.x; w.w = hi.y; return __builtin_bit_cast(bf16x8, w); }

DI void mlstm_chain(const Params& p, int l, int item, unsigned char* smem) {
    const int tid = tid_(), lane = tid & 63, w = tid >> 6, fr = lane & 15, fq = lane >> 4;
    const int b = item >> 6, hh = (item >> 3) & 7, dir = (item >> 2) & 1, sl = item & 3;
    bf16_t* Qs = (bf16_t*)smem; bf16_t* Ks = Qs + 128 * 136; bf16_t* Vs = Ks + 128 * 136; bf16_t* CTs = Vs + 128 * 72;
    float* gA = (float*)(CTs + 64 * 136); float* gPM = gA + 17 * 128; float* gBC = gPM + 17 * 128; float* gW = gBC + 17 * 128; float* nvec = gW + 128;
    const float bi = p.mbi[l * 16 + dir * 8 + hh], bff = p.mbf[l * 16 + dir * 8 + hh];
    const float* gt = p.gt; const bf16_t* P = p.P;
    bf16_t* hout = (bf16_t*)p.hm + (size_t)dir * TP * 2048;
    auto rowOf = [&](int c, int tau) -> int {
        if (dir == 0) { if (c == 0) return tau >= 112 ? META0 + b * 16 + (tau - 112) : -1; return b * 2048 + (c - 1) * 128 + tau; }
        if (c == 16) return tau < 16 ? META0 + b * 16 + (15 - tau) : -1;
        return b * 2048 + (15 - c) * 128 + (127 - tau);
    };
    for (int i = tid; i < 64 * 136 / 2; i += 512) ((unsigned*)CTs)[i] = 0u;
    if (tid < 128) nvec[tid] = 0.f;
    for (int c = w; c < 17; c += 8) {
        float li[2], lf[2];
#pragma unroll
        for (int e = 0; e < 2; ++e) { const int r = rowOf(c, 2 * lane + e);
            if (r >= 0) { const float gi = gt[(size_t)r * 32 + dir * 16 + hh], gf = gt[(size_t)r * 32 + dir * 16 + 8 + hh];
                li[e] = gi + bi; const float xf = gf + bff; lf[e] = fminf(xf, 0.f) - log1pf(__expf(-fabsf(xf))); }
            else { li[e] = -1e30f; lf[e] = 0.f; } }
        float ps = lf[0] + lf[1];
#pragma unroll
        for (int o = 1; o < 64; o <<= 1) { const float t = __shfl_up(ps, o); if (lane >= o) ps += t; }
        const float bc1 = ps, bc0 = ps - lf[1];
        const float A0 = li[0] - bc0, A1 = li[1] - bc1;
        float pmx = fmaxf(A0, A1);
#pragma unroll
        for (int o = 1; o < 64; o <<= 1) { const float t = __shfl_up(pmx, o); if (lane >= o) pmx = fmaxf(pmx, t); }
        float prev = __shfl_up(pmx, 1); if (lane == 0) prev = -3e38f;
        gA[c * 128 + 2 * lane] = A0; gA[c * 128 + 2 * lane + 1] = A1; gPM[c * 128 + 2 * lane] = fmaxf(prev, A0); gPM[c * 128 + 2 * lane + 1] = pmx;
        gBC[c * 128 + 2 * lane] = bc0; gBC[c * 128 + 2 * lane + 1] = bc1;
    }
    f32x4 cacc[4]; f32x4 nacc = {0.f, 0.f, 0.f, 0.f};
#pragma unroll
    for (int e = 0; e < 4; ++e) cacc[e] = (f32x4){0.f, 0.f, 0.f, 0.f};
    float m_st = 0.f;
    const float scale = 0.08838834764831845f;
    bf16x8 ones;
#pragma unroll
    for (int i = 0; i < 8; ++i) ones[i] = (short)0x3F80;
    u32x4 pq[4], pk[4], pv[2];
    auto fetch = [&](int c) {
#pragma unroll
        for (int i = 0; i < 4; ++i) { const int idx = tid + 512 * i; const int tau = idx >> 4, ch = idx & 15; const int r = rowOf(c, tau);
            pq[i] = (u32x4){0u, 0u, 0u, 0u}; pk[i] = (u32x4){0u, 0u, 0u, 0u};
            if (r >= 0) { pq[i] = *(const u32x4*)(P + (size_t)r * PC + oMQ + hh * 128 + ch * 8); pk[i] = *(const u32x4*)(P + (size_t)r * PC + oMK + hh * 128 + ch * 8); } }
#pragma unroll
        for (int i = 0; i < 2; ++i) { const int idx = tid + 512 * i; const int tau = idx >> 3, ch = idx & 7; const int r = rowOf(c, tau);
            pv[i] = (u32x4){0u, 0u, 0u, 0u};
            if (r >= 0) pv[i] = *(const u32x4*)(P + (size_t)r * PC + oMV + hh * 256 + sl * 64 + ch * 8); }
    };
    fetch(0);
    __syncthreads();
    for (int c = 0; c < 17; ++c) {
        const float* cA = gA + c * 128; const float* cPM = gPM + c * 128; const float* cBC = gBC + c * 128;
        const float Mend = fmaxf(m_st, cPM[127]); const float total = cBC[127];
#pragma unroll
        for (int i = 0; i < 4; ++i) { const int idx = tid + 512 * i; const int tau = idx >> 4, ch = idx & 15;
            *(u32x4*)(Qs + tau * 136 + ch * 8) = pq[i]; *(u32x4*)(Ks + tau * 136 + ch * 8) = pk[i]; }
#pragma unroll
        for (int i = 0; i < 2; ++i) { const int idx = tid + 512 * i; const int tau = idx >> 3, ch = idx & 7; *(u32x4*)(Vs + tau * 72 + ch * 8) = pv[i]; }
        if (tid < 128) gW[tid] = __expf(fminf(cA[tid] - Mend, 0.f)) * scale;
        __syncthreads();
        if (c + 1 < 17) fetch(c + 1);
        {
            const int tt = 16 * w + fr;
            const float Mt = fmaxf(m_st, cPM[tt]); const float a_t = __expf(m_st - Mt);
            bf16x8 qf[4];
#pragma unroll
            for (int kk = 0; kk < 4; ++kk) qf[kk] = *(const bf16x8*)(Qs + tt * 136 + 32 * kk + 8 * fq);
            f32x4 acc[4];
#pragma unroll
            for (int et = 0; et < 4; ++et) { acc[et] = (f32x4){0.f, 0.f, 0.f, 0.f};
#pragma unroll
                for (int kk = 0; kk < 4; ++kk) { const bf16x8 cf = *(const bf16x8*)(CTs + (16 * et + fr) * 136 + 32 * kk + 8 * fq); acc[et] = MFMA16(cf, qf[kk], acc[et]); }
                acc[et] *= a_t; }
            float qn = 0.f;
#pragma unroll
            for (int kk = 0; kk < 4; ++kk)
#pragma unroll
                for (int i = 0; i < 8; ++i) qn += bf2f(qf[kk][i]) * nvec[32 * kk + 8 * fq + i];
            float rs = 0.f;
            for (int kp = 0; kp <= (w >> 1); ++kp) {
                f32x4 s0 = {0.f, 0.f, 0.f, 0.f}, s1 = {0.f, 0.f, 0.f, 0.f};
#pragma unroll
                for (int kk = 0; kk < 4; ++kk) { const bf16x8 kf = *(const bf16x8*)(Ks + (32 * kp + fr) * 136 + 32 * kk + 8 * fq); s0 = MFMA16(kf, qf[kk], s0); }
                if (2 * kp + 1 <= w) {
#pragma unroll
                    for (int kk = 0; kk < 4; ++kk) { const bf16x8 kf = *(const bf16x8*)(Ks + (32 * kp + 16 + fr) * 136 + 32 * kk + 8 * fq); s1 = MFMA16(kf, qf[kk], s1); }
                }
                float pvv[8];
                const f32x4 ga0 = *(const f32x4*)(cA + 32 * kp + 4 * fq), ga1 = *(const f32x4*)(cA + 32 * kp + 16 + 4 * fq);
#pragma unroll
                for (int j = 0; j < 4; ++j) { const int sx = 32 * kp + 4 * fq + j; float wv = __expf(fminf(ga0[j] - Mt, 0.f)) * scale; wv = (sx <= tt) ? wv : 0.f; pvv[j] = s0[j] * wv; rs += pvv[j]; }
#pragma unroll
                for (int j = 0; j < 4; ++j) { const int sx = 32 * kp + 16 + 4 * fq + j; float wv = __expf(fminf(ga1[j] - Mt, 0.f)) * scale; wv = (sx <= tt) ? wv : 0.f; pvv[4 + j] = s1[j] * wv; rs += pvv[4 + j]; }
                u32x4 pw; pw.x = pack2(pvv[0], pvv[1]); pw.y = pack2(pvv[2], pvv[3]); pw.z = pack2(pvv[4], pvv[5]); pw.w = pack2(pvv[6], pvv[7]);
                const bf16x8 pf = __builtin_bit_cast(bf16x8, pw);
#pragma unroll
                for (int et = 0; et < 4; ++et) { const bf16x8 vf = join8(trread(Vs, 72, 32 * kp + 4 * fq, 16 * et, lane), trread(Vs, 72, 32 * kp + 16 + 4 * fq, 16 * et, lane));
                    acc[et] = MFMA16(vf, pf, acc[et]); }
            }
            rs += __shfl_xor(rs, 16); rs += __shfl_xor(rs, 32); qn += __shfl_xor(qn, 16); qn += __shfl_xor(qn, 32);
            float den = rs + a_t * qn; den = fmaxf(fabsf(den), __expf(-(cBC[tt] + Mt)));
            const float inv = 1.f / den;
            const int r = rowOf(c, tt);
            if (r >= 0) {
#pragma unroll
                for (int et = 0; et < 4; ++et) { const f32x4 o = acc[et] * inv; u32x2 ow; ow.x = pack2(o[0], o[1]); ow.y = pack2(o[2], o[3]); *(u32x2*)(hout + (size_t)r * 2048 + hh * 256 + sl * 64 + 16 * et + 4 * fq) = ow; }
            }
        }
        {
            const float decay = __expf(m_st - Mend);
#pragma unroll
            for (int et = 0; et < 4; ++et) cacc[et] *= decay;
            nacc *= decay;
#pragma unroll
            for (int kk = 0; kk < 4; ++kk) {
                const u32x2 klo = trread(Ks, 136, 32 * kk + 8 * fq, 16 * w, lane), khi = trread(Ks, 136, 32 * kk + 8 * fq + 4, 16 * w, lane);
                const f32x4 w0 = *(const f32x4*)(gW + 32 * kk + 8 * fq), w1 = *(const f32x4*)(gW + 32 * kk + 8 * fq + 4);
                u32x4 kw; kw.x = pack2(bf_lo(klo.x) * w0[0], bf_hi(klo.x) * w0[1]); kw.y = pack2(bf_lo(klo.y) * w0[2], bf_hi(klo.y) * w0[3]);
                kw.z = pack2(bf_lo(khi.x) * w1[0], bf_hi(khi.x) * w1[1]); kw.w = pack2(bf_lo(khi.y) * w1[2], bf_hi(khi.y) * w1[3]);
                const bf16x8 kt = __builtin_bit_cast(bf16x8, kw);
                nacc = MFMA16(kt, ones, nacc);
#pragma unroll
                for (int et = 0; et < 4; ++et) { const bf16x8 vt = join8(trread(Vs, 72, 32 * kk + 8 * fq, 16 * et, lane), trread(Vs, 72, 32 * kk + 8 * fq + 4, 16 * et, lane)); cacc[et] = MFMA16(kt, vt, cacc[et]); } }
        }
        __syncthreads();
#pragma unroll
        for (int et = 0; et < 4; ++et) { u32x2 cw; cw.x = pack2(cacc[et][0], cacc[et][1]); cw.y = pack2(cacc[et][2], cacc[et][3]); *(u32x2*)(CTs + (16 * et + fr) * 136 + 16 * w + 4 * fq) = cw; }
        if (fr == 0) *(f32x4*)(nvec + 16 * w + 4 * fq) = nacc;
        m_st = total + Mend;
    }
    __syncthreads();
}

DI u32x4 rope8(u32x4 self, u32x4 other, int ch, const float* cs, const float* sn, float mul) {
    const float sgn = ch == 0 ? -1.f : 1.f;
    const f32x4 c0 = *(const f32x4*)cs, c1 = *(const f32x4*)(cs + 4), s0 = *(const f32x4*)sn, s1 = *(const f32x4*)(sn + 4);
    u32x4 o;
    o.x = pack2((bf_lo(self.x) * c0[0] + sgn * bf_lo(other.x) * s0[0]) * mul, (bf_hi(self.x) * c0[1] + sgn * bf_hi(other.x) * s0[1]) * mul);
    o.y = pack2((bf_lo(self.y) * c0[2] + sgn * bf_lo(other.y) * s0[2]) * mul, (bf_hi(self.y) * c0[3] + sgn * bf_hi(other.y) * s0[3]) * mul);
    o.z = pack2((bf_lo(self.z) * c1[0] + sgn * bf_lo(other.z) * s1[0]) * mul, (bf_hi(self.z) * c1[1] + sgn * bf_hi(other.z) * s1[1]) * mul);
    o.w = pack2((bf_lo(self.w) * c1[2] + sgn * bf_lo(other.w) * s1[2]) * mul, (bf_hi(self.w) * c1[3] + sgn * bf_hi(other.w) * s1[3]) * mul);
    return o;
}
DI u32x4 scale8(u32x4 v, float mul) {
    u32x4 o; o.x = pack2(bf_lo(v.x) * mul, bf_hi(v.x) * mul); o.y = pack2(bf_lo(v.y) * mul, bf_hi(v.y) * mul); o.z = pack2(bf_lo(v.z) * mul, bf_hi(v.z) * mul); o.w = pack2(bf_lo(v.w) * mul, bf_hi(v.w) * mul);
    return o;
}

DI void attn_item(const Params& p, int l, int it, unsigned char* smem) {
    const int tid = tid_(), lane = tid & 63, w = tid >> 6, fr = lane & 15, fq = lane >> 4;
    bf16_t* Ks = (bf16_t*)smem;
    bf16_t* Vs = Ks + 416 * 72;
    const bf16_t* P = p.P;
    int b, kvh, j, meta;
    if (it < 512) { b = it >> 7; kvh = (it >> 4) & 7; j = it & 15; meta = 0; } else { const int x = it - 512; b = x >> 3; kvh = x & 7; j = 0; meta = 1; }
    const int r_begin = meta ? 0 : (j == 0 ? 128 : 0);
    const int r_end = meta ? 128 : (j == 15 ? 256 : 384);
    const int kbase = meta ? 0 : (j - 1) * 128;
    const int nslots = 16 + r_end - r_begin; const int nsteps = (nslots + 31) >> 5; const int nrows = nsteps * 32;
    {
        u32x4 kv[7], vv[7], ov[7];
#pragma unroll
        for (int i = 0; i < 7; ++i) { const int idx = tid + 512 * i; const int slot = idx >> 3, ch = idx & 7;
            kv[i] = (u32x4){0u, 0u, 0u, 0u}; vv[i] = kv[i]; ov[i] = kv[i];
            if (slot < nslots) { const int row = slot < 16 ? META0 + b * 16 + slot : b * 2048 + kbase + r_begin + slot - 16;
                const bf16_t* kp = P + (size_t)row * PC + oAK + kvh * 64;
                kv[i] = *(const u32x4*)(kp + ch * 8); vv[i] = *(const u32x4*)(P + (size_t)row * PC + oAV + kvh * 64 + ch * 8);
                if (ch < 2) ov[i] = *(const u32x4*)(kp + (ch ^ 1) * 8); } }
#pragma unroll
        for (int i = 0; i < 7; ++i) { const int idx = tid + 512 * i; const int slot = idx >> 3, ch = idx & 7;
            if (idx < nrows * 8) {
                u32x4 kk = kv[i];
                if (slot < nslots && ch < 2) { const int pos = slot < 16 ? slot : 16 + kbase + r_begin + slot - 16; kk = rope8(kk, ov[i], ch, p.ropec + pos * 8, p.ropes + pos * 8, 1.f); }
                *(u32x4*)(Ks + slot * 72 + ch * 8) = kk; *(u32x4*)(Vs + slot * 72 + ch * 8) = vv[i]; } }
    }
    const int nq = meta ? (w < 4 ? 1 : 0) : 4;
    const int A0 = 16 * w;
    int qlo, qhi, qrow;
    { int pos;
      if (!meta) { const int a = A0 + fr; qrow = b * 2048 + j * 128 + a; pos = 16 + j * 128 + a; qlo = a; qhi = a + 256; }
      else { qrow = META0 + b * 16 + fr; pos = fr; qlo = -1; qhi = 112 + fr; }
      (void)pos; }
    const int qpos = meta ? fr : 16 + j * 128 + A0 + fr;
    const unsigned qspan = (unsigned)(qhi - qlo);
    bf16x8 qf[4][2]; float skv[4];
#pragma unroll
    for (int qt = 0; qt < 4; ++qt) { qf[qt][0] = qf[qt][1] = (bf16x8){0, 0, 0, 0, 0, 0, 0, 0}; skv[qt] = 0.f;
        if (qt < nq) { const int head = kvh * 4 + (meta ? w : qt);
            skv[qt] = p.sink[l * 32 + head];
            const bf16_t* qp = P + (size_t)qrow * PC + oAQ + head * 64;
            u32x4 q0 = *(const u32x4*)(qp + 8 * fq); u32x4 q1 = *(const u32x4*)(qp + 32 + 8 * fq);
            if (fq < 2) { const u32x4 ov = *(const u32x4*)(qp + 8 * (fq ^ 1)); q0 = rope8(q0, ov, fq, p.ropec + qpos * 8, p.ropes + qpos * 8, 0.125f); } else q0 = scale8(q0, 0.125f);
            q1 = scale8(q1, 0.125f);
            qf[qt][0] = __builtin_bit_cast(bf16x8, q0); qf[qt][1] = __builtin_bit_cast(bf16x8, q1); } }
    float mrun[4], lrun[4];
#pragma unroll
    for (int qt = 0; qt < 4; ++qt) { mrun[qt] = -1e30f; lrun[qt] = 0.f; }
    __syncthreads();
    auto step_mode = [&](int st) -> int {
        if (meta || st == 0) return 2;
        const int R0 = r_begin + 32 * st - 16, R1 = R0 + 31;
        if (R1 < A0 || R0 > A0 + 15 + 256) return 0;
        if (R0 >= A0 + 15 && R1 <= A0 + 256 && 32 * st + 31 < nslots) return 1;
        return 2;
    };
#define ATT_PEN(st, pen) do { _Pragma("unroll") for (int e_ = 0; e_ < 8; ++e_) { const int slot_ = 32 * (st) + 16 * (e_ >> 2) + 4 * fq + (e_ & 3); const int r_ = r_begin + slot_ - 16; \
        const bool vis_ = (slot_ < 16) || (slot_ < nslots && (unsigned)(r_ - qlo) <= qspan); pen[e_] = vis_ ? 0.f : -1e30f; } } while (0)
#define ATT_S4(s0, s1) do { \
        _Pragma("unroll") for (int q_ = 0; q_ < 4; ++q_) { s0[q_] = (f32x4){0.f, 0.f, 0.f, 0.f}; s1[q_] = (f32x4){0.f, 0.f, 0.f, 0.f}; } \
        _Pragma("unroll") for (int q_ = 0; q_ < 4; ++q_) if (q_ < nq) s0[q_] = MFMA16(kf[0][0], qf[q_][0], s0[q_]); \
        _Pragma("unroll") for (int q_ = 0; q_ < 4; ++q_) if (q_ < nq) s1[q_] = MFMA16(kf[1][0], qf[q_][0], s1[q_]); \
        _Pragma("unroll") for (int q_ = 0; q_ < 4; ++q_) if (q_ < nq) s0[q_] = MFMA16(kf[0][1], qf[q_][1], s0[q_]); \
        _Pragma("unroll") for (int q_ = 0; q_ < 4; ++q_) if (q_ < nq) s1[q_] = MFMA16(kf[1][1], qf[q_][1], s1[q_]); } while (0)
    for (int st = 0; st < nsteps; ++st) {
        const int mode = step_mode(st);
        if (mode == 0) continue;
        bf16x8 kf[2][2];
#pragma unroll
        for (int tl = 0; tl < 2; ++tl)
#pragma unroll
            for (int kk = 0; kk < 2; ++kk) kf[tl][kk] = *(const bf16x8*)(Ks + (32 * st + 16 * tl + fr) * 72 + 32 * kk + 8 * fq);
        float pen[8];
        if (mode == 2) ATT_PEN(st, pen); else {
#pragma unroll
            for (int e = 0; e < 8; ++e) pen[e] = 0.f; }
        f32x4 s0[4], s1[4];
        ATT_S4(s0, s1);
#pragma unroll
        for (int qt = 0; qt < 4; ++qt) {
            if (qt < nq) { float sv[8];
#pragma unroll
                for (int e = 0; e < 8; ++e) { float v = (e >> 2) ? s1[qt][e & 3] : s0[qt][e & 3]; if (mode == 2) v += pen[e]; sv[e] = v; }
                mrun[qt] = fmaxf(mrun[qt], fmaxf(fmaxf(fmaxf(sv[0], sv[1]), fmaxf(sv[2], sv[3])), fmaxf(fmaxf(sv[4], sv[5]), fmaxf(sv[6], sv[7])))); }
        }
    }
#pragma unroll
    for (int qt = 0; qt < 4; ++qt) { float m = mrun[qt]; m = fmaxf(m, __shfl_xor(m, 16)); m = fmaxf(m, __shfl_xor(m, 32)); mrun[qt] = fmaxf(m, skv[qt]); }
    f32x4 O[4][4];
#pragma unroll
    for (int qt = 0; qt < 4; ++qt)
#pragma unroll
        for (int dt = 0; dt < 4; ++dt) O[qt][dt] = (f32x4){0.f, 0.f, 0.f, 0.f};
    for (int st = 0; st < nsteps; ++st) {
        const int mode = step_mode(st);
        if (mode == 0) continue;
        bf16x8 kf[2][2], vf[4];
#pragma unroll
        for (int tl = 0; tl < 2; ++tl)
#pragma unroll
            for (int kk = 0; kk < 2; ++kk) kf[tl][kk] = *(const bf16x8*)(Ks + (32 * st + 16 * tl + fr) * 72 + 32 * kk + 8 * fq);
#pragma unroll
        for (int dt = 0; dt < 4; ++dt) vf[dt] = join8(trread(Vs, 72, 32 * st + 4 * fq, 16 * dt, lane), trread(Vs, 72, 32 * st + 16 + 4 * fq, 16 * dt, lane));
        float pen[8];
        if (mode == 2) ATT_PEN(st, pen); else {
#pragma unroll
            for (int e = 0; e < 8; ++e) pen[e] = 0.f; }
        f32x4 s0[4], s1[4];
        ATT_S4(s0, s1);
        bf16x8 pf[4];
#pragma unroll
        for (int qt = 0; qt < 4; ++qt) {
            pf[qt] = (bf16x8){0, 0, 0, 0, 0, 0, 0, 0};
            if (qt < nq) { float ps = 0.f; float pv[8];
#pragma unroll
                for (int e = 0; e < 8; ++e) { float v = (e >> 2) ? s1[qt][e & 3] : s0[qt][e & 3]; if (mode == 2) v += pen[e]; pv[e] = __expf(v - mrun[qt]); ps += pv[e]; }
                lrun[qt] += ps;
                u32x4 pw; pw.x = pack2(pv[0], pv[1]); pw.y = pack2(pv[2], pv[3]); pw.z = pack2(pv[4], pv[5]); pw.w = pack2(pv[6], pv[7]);
                pf[qt] = __builtin_bit_cast(bf16x8, pw); }
        }
#pragma unroll
        for (int dt = 0; dt < 4; ++dt)
#pragma unroll
            for (int qt = 0; qt < 4; ++qt)
                if (qt < nq) O[qt][dt] = MFMA16(vf[dt], pf[qt], O[qt][dt]);
    }
#undef ATT_S4
#undef ATT_PEN
#pragma unroll
    for (int qt = 0; qt < 4; ++qt) {
        if (qt < nq) {
            const int head = kvh * 4 + (meta ? w : qt);
            float ls = lrun[qt]; ls += __shfl_xor(ls, 16); ls += __shfl_xor(ls, 32);
            const float sc = 1.f / (ls + __expf(skv[qt] - mrun[qt]));
#pragma unroll
            for (int dt = 0; dt < 4; ++dt) { const f32x4 o = O[qt][dt] * sc; u32x2 ow; ow.x = pack2(o[0], o[1]); ow.y = pack2(o[2], o[3]);
                *(u32x2*)(p.ya + (size_t)qrow * 2048 + head * 64 + 16 * dt + 4 * fq) = ow; }
        }
    }
    __syncthreads();
}

DI void mixer_post(const Params& p, int l) {
    const int tid = tid_(), lane = tid & 63;
    const int gw = (blockIdx.x * 512 + tid) >> 6, nw = gridDim.x * 8;
    const bf16_t* hm0 = (const bf16_t*)p.hm; const bf16_t* hm1 = hm0 + (size_t)TP * 2048;
    for (int row = gw; row < TOK; row += nw) {
        f32x4 v[8]; u32x2 ob[8];
#pragma unroll
        for (int hh = 0; hh < 8; ++hh) { const int col = hh * 256 + lane * 4;
            { const u32x2 a = *(const u32x2*)(hm0 + (size_t)row * 2048 + col), b2 = *(const u32x2*)(hm1 + (size_t)row * 2048 + col);
              v[hh] = (f32x4){bf_lo(a.x) + bf_lo(b2.x), bf_hi(a.x) + bf_hi(b2.x), bf_lo(a.y) + bf_lo(b2.y), bf_hi(a.y) + bf_hi(b2.y)}; }
            ob[hh] = *(const u32x2*)(p.P + (size_t)row * PC + oMO + col); }
#pragma unroll
        for (int hh = 0; hh < 8; ++hh) { const int col = hh * 256 + lane * 4;
            float ss = v[hh][0] * v[hh][0] + v[hh][1] * v[hh][1] + v[hh][2] * v[hh][2] + v[hh][3] * v[hh][3]; ss = wave_sum(ss);
            const float r = rsqrtf(ss * (1.f / 256.f) + 1e-6f);
            const f32x4 gn = *(const f32x4*)(p.gain + (size_t)l * 2048 + col);
            u32x2 ow; ow.x = pack2(v[hh][0] * r * gn[0] * sigmoidf_(bf_lo(ob[hh].x)), v[hh][1] * r * gn[1] * sigmoidf_(bf_hi(ob[hh].x)));
            ow.y = pack2(v[hh][2] * r * gn[2] * sigmoidf_(bf_lo(ob[hh].y)), v[hh][3] * r * gn[3] * sigmoidf_(bf_hi(ob[hh].y)));
            *(u32x2*)(p.ym + (size_t)row * 2048 + col) = ow; }
    }
    const int gtid = blockIdx.x * 512 + tid, gstride = gridDim.x * 512;
    const float* cw = p.conv_w + (size_t)l * 3 * 2048; const float* cb = p.conv_b + (size_t)l * 2048;
    for (int idx = gtid; idx < TOK * 256; idx += gstride) { const int row = idx >> 8, c0 = (idx & 255) * 8;
        int prow, nrow;
        if (row < META0) { const int bb = row >> 11, s = row & 2047; prow = s == 0 ? META0 + bb * 16 + 15 : row - 1; nrow = s == 2047 ? -1 : row + 1; }
        else { const int bb = (row - META0) >> 4, m = (row - META0) & 15; prow = m == 0 ? -1 : row - 1; nrow = m == 15 ? bb * 2048 : row + 1; }
        const bf16_t* pr = p.P + (size_t)row * PC + c0;
        const u32x4 x1 = *(const u32x4*)(pr + oCX), b1 = *(const u32x4*)(pr + oCB);
        u32x4 xp = {0u, 0u, 0u, 0u}, xq = xp;
        if (prow >= 0) xp = *(const u32x4*)(p.P + (size_t)prow * PC + c0 + oCX);
        if (nrow >= 0) xq = *(const u32x4*)(p.P + (size_t)nrow * PC + c0 + oCX);
        const f32x4 w0a = *(const f32x4*)(cw + c0), w0b = *(const f32x4*)(cw + c0 + 4), w1a = *(const f32x4*)(cw + 2048 + c0), w1b = *(const f32x4*)(cw + 2048 + c0 + 4);
        const f32x4 w2a = *(const f32x4*)(cw + 4096 + c0), w2b = *(const f32x4*)(cw + 4096 + c0 + 4), ba = *(const f32x4*)(cb + c0), bbv = *(const f32x4*)(cb + c0 + 4);
        u32x4 o;
#pragma unroll
        for (int k = 0; k < 4; ++k) {
            const float w0l = k < 2 ? w0a[2 * k] : w0b[2 * k - 4], w0h = k < 2 ? w0a[2 * k + 1] : w0b[2 * k - 3];
            const float w1l = k < 2 ? w1a[2 * k] : w1b[2 * k - 4], w1h = k < 2 ? w1a[2 * k + 1] : w1b[2 * k - 3];
            const float w2l = k < 2 ? w2a[2 * k] : w2b[2 * k - 4], w2h = k < 2 ? w2a[2 * k + 1] : w2b[2 * k - 3];
            const float bl = k < 2 ? ba[2 * k] : bbv[2 * k - 4], bh = k < 2 ? ba[2 * k + 1] : bbv[2 * k - 3];
            const float ul = bf_lo(x1[k]), uh = bf_hi(x1[k]);
            const float pl = bf_lo(xp[k]), ph = bf_hi(xp[k]);
            const float nl = bf_lo(xq[k]), nh = bf_hi(xq[k]);
            const float yl = bf_lo(b1[k]) * (pl * w0l + ul * w1l + nl * w2l + bl), yh = bf_hi(b1[k]) * (ph * w0h + uh * w1h + nh * w2h + bh);
            o[k] = pack2(yl, yh);
        }
        *(u32x4*)(p.yc + (size_t)row * 2048 + c0) = o; }
}

__global__ void __launch_bounds__(512, 2) fwd_megakernel(Params p) {
    extern __shared__ __attribute__((aligned(16))) unsigned char smem[];
    cg::grid_group grid = cg::this_grid();
    LAS unsigned char* lds = (LAS unsigned char*)smem;
    const int G = gridDim.x, c = blockIdx.x;
    volatile LAS unsigned* xst = (volatile LAS unsigned*)(lds + LDS_BYTES - 16);
    if (threadIdx.x < 4) xst[threadIdx.x] = 0u;
    __syncthreads();
    const XcdBarrier xb = xcd_barrier_post(p.bar, xst);
    phase0(p, smem);
    if (p.out == nullptr) grid.sync();
    xcd_barrier(xb);
    for (int l = 0; l < 2; ++l) {
        if (l > 0) { norm_phase(p, p.nmix + (size_t)l * 2048); xcd_barrier(xb); }
        {
            pg8::Sched S; S.init(TP, NIN, 2048, G, c, 1); S.A0 = (const char*)p.xn; S.B0 = (const char*)(p.Wt_in + (size_t)l * NIN * 2048);
            EpiIn E; E.P = p.P; E.G = p.G; E.gt = p.gt; E.bgate = p.b_gate + (size_t)l * GC;
            pg8::gemm_phase<EpiIn>(lds, 2048, S, E);
        }
        xcd_barrier(xb);
        const int cx = (G % 8 == 0) ? (c % 8) * (G / 8) + c / 8 : c;
        for (int it = cx; it < 256; it += G) mlstm_chain(p, l, it, smem);
        for (int it = cx; it < (l == 1 ? 512 : 544); it += G) attn_item(p, l, it, smem);
        xcd_barrier(xb);
        constexpr int MR = META0;
        mixer_post(p, l);
        xcd_barrier(xb);
        {
            const size_t sq = (size_t)l * 2048 * 2048;
            pg8::Sched S; S.init(MR, 2048, 2048, G, c, 3); S.A0 = (const char*)p.yc; S.zA = (size_t)TP * 2048 * 2;
            S.B0 = (const char*)(p.Wt_c + sq); S.zB = (size_t)2 * 2048 * 2048 * 2;
            EpiBr E; E.G = p.G; E.mg = p.mg;
            pg8::gemm_phase<EpiBr>(lds, 2048, S, E);
            if (l == 0) { ThinBr T; T.G = p.G; T.mg = p.mg; thin_gemm<ThinBr, 4, 1>(p.yc + (size_t)META0 * 2048, 2048, p.Wt_c + sq, 2048, 2048, 1, 3, (size_t)TP * 2048, (size_t)2 * 2048 * 2048, T, smem); }
        }
        xcd_barrier(xb);
        {
            pg8::Sched S; S.init(MR, 2048, 2048, G, c, 1); S.A0 = (const char*)p.mg; S.B0 = (const char*)(p.Wt_o + (size_t)l * 2048 * 2048);
            EpiRes E; E.h = p.h;
            pg8::gemm_phase<EpiRes>(lds, 2048, S, E);
            if (l == 0) { ThinRes T; T.h = p.h; thin_gemm<ThinRes, 2, 4>(p.mg + (size_t)META0 * 2048, 2048, p.Wt_o, 2048, 2048, 2, 1, 0, 0, T, smem); }
        }
        xcd_barrier(xb);
        norm_phase(p, p.nmlp + (size_t)l * 2048);
        xcd_barrier(xb);
        {
            pg8::Sched S; S.init(MR, HID, 2048, G, c, 1); S.A0 = (const char*)p.xn; S.B0 = (const char*)(p.Wt1 + (size_t)l * 2048 * HID);
            EpiUp E; E.act = p.P;
            pg8::gemm_phase<EpiUp>(lds, 2048, S, E);
            if (l == 0) { ThinUp T; T.act = p.P; thin_gemm<ThinUp, 2, 4>(p.xn + (size_t)META0 * 2048, 2048, p.Wt1, 2048, HID, 1, 1, 0, 0, T, smem); }
        }
        xcd_barrier(xb);
        {
            pg8::Sched S; S.init(MR, 2048, HID, G, c, 1); S.A0 = (const char*)p.P; S.B0 = (const char*)(p.Wt2 + (size_t)l * 2048 * HID);
            EpiRes E; E.h = p.h;
            pg8::gemm_phase<EpiRes>(lds, HID, S, E);
            if (l == 0) { ThinRes T; T.h = p.h; thin_gemm<ThinRes, 2, 4>(p.P + (size_t)META0 * HID, HID, p.Wt2, HID, 2048, 8, 1, 0, 0, T, smem); }
        }
        xcd_barrier(xb);
    }
    final_phase(p);
}

extern "C" void kernel_launch(void* const* d_in, const int* in_sizes, int n_in, void* d_out, int out_size, void* d_ws, size_t ws_size, hipStream_t stream) {
    static int grid_blocks = 0;
    if (!grid_blocks) {
        int dev = 0, cus = 0, per_cu = 0;
        hipGetDevice(&dev);
        hipDeviceGetAttribute(&cus, hipDeviceAttributeMultiprocessorCount, dev);
        hipFuncSetAttribute((const void*)fwd_megakernel, hipFuncAttributeMaxDynamicSharedMemorySize, LDS_BYTES);
        hipOccupancyMaxActiveBlocksPerMultiprocessor(&per_cu, (const void*)fwd_megakernel, 512, LDS_BYTES);
        if (per_cu < 1) per_cu = 1;
        if (per_cu > 1) per_cu = 1;
        grid_blocks = cus * per_cu;
    }
    Params p{};
    const float* const* in = (const float* const*)d_in;
    p.x = in[0]; p.meta = in[1]; p.w_in = in[2]; p.b_gate = in[3]; p.conv_w = in[4]; p.conv_b = in[5]; p.sink = in[6]; p.mbi = in[7]; p.mbf = in[8]; p.gain = in[9];
    p.w_cp = in[10]; p.w_ap = in[11]; p.w_mp = in[12]; p.w_out = in[13]; p.nmix = in[14]; p.nmlp = in[15]; p.w1 = in[16]; p.w2 = in[17]; p.fnorm = in[18];
    p.out = (float*)d_out;
    unsigned char* ws = (unsigned char*)d_ws; size_t off = 0;
    auto take = [&](size_t bytes) { unsigned char* r = ws + off; off += (bytes + 255) & ~(size_t)255; return r; };
    p.Wt_in = (bf16_t*)take((size_t)2 * NIN * 2048 * 2);
    p.Wt_c = (bf16_t*)take((size_t)2 * 2048 * 2048 * 2); p.Wt_a = (bf16_t*)take((size_t)2 * 2048 * 2048 * 2);
    p.Wt_m = (bf16_t*)take((size_t)2 * 2048 * 2048 * 2); p.Wt_o = (bf16_t*)take((size_t)2 * 2048 * 2048 * 2);
    p.Wt1 = (bf16_t*)take((size_t)2 * 2048 * HID * 2); p.Wt2 = (bf16_t*)take((size_t)2 * 2048 * HID * 2);
    p.h = (float*)take((size_t)TP * 2048 * 4); p.xn = (bf16_t*)take((size_t)TP * 2048 * 2);
    p.P = (bf16_t*)take((size_t)TP * PC * 2); p.G = (bf16_t*)take((size_t)TP * GC * 2); p.gt = (float*)take((size_t)TP * 32 * 4);
    p.yc = (bf16_t*)take((size_t)TP * 2048 * 2); p.ya = (bf16_t*)take((size_t)TP * 2048 * 2); p.ym = (bf16_t*)take((size_t)TP * 2048 * 2);
    p.hm = (float*)take((size_t)2 * TP * 2048 * 4); p.mg = (bf16_t*)take((size_t)TP * 2048 * 2);
    p.ropec = (float*)take(2064 * 8 * 4); p.ropes = (float*)take(2064 * 8 * 4);
    p.bar = (unsigned*)take(XCD_BAR_WORDS * 4);
    if (off > ws_size) { fprintf(stderr, "kernel_launch: workspace too small: need %zu, have %zu\n", off, ws_size); return; }
    if (hipMemsetAsync(p.bar, 0, XCD_BAR_WORDS * 4, stream) != hipSuccess) { fprintf(stderr, "kernel_launch: memset of the barrier words failed\n"); return; }
    void* args[] = {&p};
    hipError_t e = hipLaunchCooperativeKernel((const void*)fwd_megakernel, dim3(grid_blocks), dim3(512), args, LDS_BYTES, stream);
    if (e != hipSuccess) fprintf(stderr, "cooperative launch failed: %s (grid %d)\n", hipGetErrorString(e), grid_blocks);
}
```
